# Optimizing an MI355X kernel written in HIP

```python
import jax, jax.numpy as jnp
from jax import lax
import numpy as np

D_MODEL = 2048
BATCH = 8
SEQ = 4096
DEPTH = 4

D_RWKV = D_MODEL // 2
D_POOL = D_MODEL - D_RWKV
HEAD_SIZE = 64
N_HEADS = D_RWKV // HEAD_SIZE
DECAY_LORA = 64
ICLR_LORA = 64
VRES_LORA = 32
POOL_WINDOWS = (2, 4, 8, 16)
N_POOL_GROUPS = len(POOL_WINDOWS)
POOL_GROUP_DIM = D_POOL // N_POOL_GROUPS
D_PLE = 256
N_SHIFT = 3 * D_RWKV + DECAY_LORA + ICLR_LORA
N_IN = N_SHIFT + D_RWKV + 2 * D_POOL
RMS_EPS = 1e-6
GN_EPS = 64e-5
KK_EPS = 1e-12

kernel_name = "hybrid_rwkv7_multiscale_pool_trunk"


def rms_norm(x, g):
    xf = x.astype(jnp.float32)
    y = xf * lax.rsqrt(jnp.mean(xf * xf, axis=-1, keepdims=True) + RMS_EPS)
    return (y * g.astype(jnp.float32)).astype(x.dtype)


def token_shift(s):
    return jnp.pad(s, ((0, 0), (1, 0), (0, 0)))[:, :-1]


def wkv7_scan(r, w, k, v, kk, a):
    B, T, H, N = r.shape

    def step(S, inp):
        r_t, w_t, k_t, v_t, kk_t, a_t = inp
        sa = jnp.einsum('bhvk,bhk->bhv', S, -kk_t)
        S = (S * w_t[:, :, None, :]
             + sa[..., None] * (kk_t * a_t)[:, :, None, :]
             + v_t[..., None] * k_t[:, :, None, :])
        y_t = jnp.einsum('bhvk,bhk->bhv', S, r_t)
        return S, y_t

    xs = tuple(jnp.moveaxis(t, 1, 0) for t in (r, w, k, v, kk, a))
    S0 = jnp.zeros((B, H, N, N), jnp.float32)
    _, ys = lax.scan(step, S0, xs)
    return jnp.moveaxis(ys, 0, 1)


def head_group_norm(y, w, b):
    B, T, H, N = y.shape
    mean = jnp.mean(y, axis=-1, keepdims=True)
    var = jnp.mean(jnp.square(y - mean), axis=-1, keepdims=True)
    yn = (y - mean) * lax.rsqrt(var + GN_EPS)
    return yn.reshape(B, T, H * N) * w.astype(jnp.float32) + b.astype(jnp.float32)


def causal_multiscale_pool(u):
    B, T, _ = u.shape
    ug = u.astype(jnp.float32).reshape(B, T, N_POOL_GROUPS, POOL_GROUP_DIM)
    c = jnp.cumsum(ug, axis=1)
    pos = jnp.arange(1, T + 1, dtype=jnp.float32)
    means = []
    for g, win in enumerate(POOL_WINDOWS):
        cg = c[:, :, g]
        prev = jnp.pad(cg, ((0, 0), (win, 0), (0, 0)))[:, :T]
        cnt = jnp.minimum(pos, jnp.float32(win))
        means.append((cg - prev) / cnt[None, :, None])
    mean = jnp.stack(means, axis=2)
    return mean - ug


def setup_inputs(seed: int = 0) -> dict:
    key = jax.random.key(seed)
    ks = jax.random.split(key, 24)
    f32 = jnp.float32
    nrm = lambda k, s, sc: jax.random.normal(k, s, f32) * sc
    L = DEPTH
    return {
        "x": nrm(ks[0], (BATCH, SEQ, D_MODEL), 1.0),
        "p": nrm(ks[1], (DEPTH, BATCH, SEQ, D_PLE), 1.0),
        "norm_g": 1.0 + nrm(ks[2], (L, D_MODEL), 0.02),
        "w_in": nrm(ks[3], (L, D_MODEL, N_IN), D_MODEL ** -0.5),
        "mu": jax.random.uniform(ks[4], (L, N_SHIFT), f32),
        "w0": jax.random.uniform(ks[5], (L, D_RWKV), f32, minval=-6.0, maxval=1.0),
        "w_up": nrm(ks[6], (L, DECAY_LORA, D_RWKV), 0.1 * DECAY_LORA ** -0.5),
        "a0": nrm(ks[7], (L, D_RWKV), 0.1),
        "a_up": nrm(ks[8], (L, ICLR_LORA, D_RWKV), 0.1 * ICLR_LORA ** -0.5),
        "v0": nrm(ks[9], (L - 1, D_RWKV), 0.1),
        "v_down": nrm(ks[10], (L - 1, D_RWKV, VRES_LORA), D_RWKV ** -0.5),
        "v_up": nrm(ks[11], (L - 1, VRES_LORA, D_RWKV), 0.5 * VRES_LORA ** -0.5),
        "k_k": 0.85 + nrm(ks[12], (L, D_RWKV), 0.02),
        "k_a": 1.0 + nrm(ks[13], (L, D_RWKV), 0.02),
        "r_k": nrm(ks[14], (L, N_HEADS, HEAD_SIZE), 0.1),
        "ln_w": 1.0 + nrm(ks[15], (L, D_RWKV), 0.02),
        "ln_b": nrm(ks[16], (L, D_RWKV), 0.01),
        "w_pool": nrm(ks[17], (L, N_POOL_GROUPS, POOL_GROUP_DIM, POOL_GROUP_DIM), POOL_GROUP_DIM ** -0.5),
        "pool_scale": 0.5 + nrm(ks[18], (L, D_POOL), 0.05),
        "w_out": nrm(ks[19], (L, D_MODEL, D_MODEL), D_MODEL ** -0.5),
        "w_ple": nrm(ks[20], (L, D_PLE, D_MODEL), D_PLE ** -0.5),
        "w_pg": nrm(ks[21], (L, D_MODEL, D_MODEL), D_MODEL ** -0.5),
        "b_pg": nrm(ks[22], (L, D_MODEL), 0.01),
        "final_g": 1.0 + nrm(ks[23], (D_MODEL,), 0.02),
    }


def reference(x, p, norm_g, w_in, mu, w0, w_up, a0, a_up, v0, v_down, v_up, k_k, k_a, r_k,
              ln_w, ln_b, w_pool, pool_scale, w_out, w_ple, w_pg, b_pg, final_g):
    B, T, _ = x.shape
    dt = x.dtype
    f32 = jnp.float32
    v_first = None
    o1 = D_RWKV
    o2 = 2 * D_RWKV
    o3 = 3 * D_RWKV
    o4 = o3 + DECAY_LORA
    for i in range(DEPTH):
        h = rms_norm(x, norm_g[i])
        z = jnp.einsum('btd,dn->btn', h, w_in[i])
        zs = z[..., :N_SHIFT]
        g_rwkv = z[..., N_SHIFT:N_SHIFT + D_RWKV]
        u = z[..., N_SHIFT + D_RWKV:N_SHIFT + D_RWKV + D_POOL]
        g_pool = z[..., N_SHIFT + D_RWKV + D_POOL:]

        zs = zs + (token_shift(zs) - zs) * mu[i]
        r = zs[..., :o1]
        k = zs[..., o1:o2]
        v = zs[..., o2:o3]
        wd = zs[..., o3:o4]
        ad = zs[..., o4:]
        w_loglog = -jax.nn.softplus(-(w0[i] + jnp.tanh(wd) @ w_up[i])) - 0.5
        decay = jnp.exp(-jnp.exp(w_loglog.astype(f32)))
        a = jax.nn.sigmoid(a0[i] + ad @ a_up[i])
        if i == 0:
            v_first = v
        else:
            nu = jax.nn.sigmoid(v0[i - 1] + (v @ v_down[i - 1]) @ v_up[i - 1])
            v = v + (v_first - v) * nu
        kk = (k * k_k[i]).astype(f32).reshape(B, T, N_HEADS, HEAD_SIZE)
        kk = kk / jnp.maximum(jnp.linalg.norm(kk, axis=-1, keepdims=True), KK_EPS)
        k = k * (1.0 + (a - 1.0) * k_a[i])
        rh = r.astype(f32).reshape(B, T, N_HEADS, HEAD_SIZE)
        kh = k.astype(f32).reshape(B, T, N_HEADS, HEAD_SIZE)
        vh = v.astype(f32).reshape(B, T, N_HEADS, HEAD_SIZE)
        ah = a.astype(f32).reshape(B, T, N_HEADS, HEAD_SIZE)
        wh = decay.reshape(B, T, N_HEADS, HEAD_SIZE)
        y = wkv7_scan(rh, wh, kh, vh, kk, ah)
        y = head_group_norm(y, ln_w[i], ln_b[i])
        bonus = jnp.sum(rh * kh * r_k[i].astype(f32), axis=-1, keepdims=True) * vh
        y_rwkv = (y + bonus.reshape(B, T, D_RWKV)).astype(dt) * jax.nn.silu(g_rwkv)

        d = causal_multiscale_pool(u).astype(dt)
        y_pool = jnp.einsum('btgc,gcd->btgd', d, w_pool[i]).reshape(B, T, D_POOL)
        y_pool = y_pool * pool_scale[i] * jax.nn.silu(g_pool)

        y_mix = jnp.concatenate([y_rwkv, y_pool], axis=-1)
        x = x + jnp.einsum('btc,cd->btd', y_mix, w_out[i])

        gate = jax.nn.sigmoid(jnp.einsum('btd,de->bte', x, w_pg[i]) + b_pg[i])
        x = x + gate * jnp.einsum('btq,qd->btd', p[i], w_ple[i])

    return rms_norm(x, final_g)
```

```cpp
#include <hip/hip_runtime.h>
#include <hip/hip_cooperative_groups.h>
#include <cstdio>
namespace cg = cooperative_groups;

#define LAS __attribute__((address_space(3)))
typedef _Float16 f16;
typedef _Float16 f16x8 __attribute__((ext_vector_type(8)));
typedef _Float16 f16x4 __attribute__((ext_vector_type(4)));
typedef float f32x4 __attribute__((ext_vector_type(4)));
typedef unsigned u32x4 __attribute__((ext_vector_type(4)));

constexpr int NB = 8, T = 4096, M = NB * T, D = 2048, DR = 1024, NZ = 6400;
constexpr size_t MiB = 1u << 20;
constexpr size_t OFF_WIN = 0;
constexpr size_t OFF_WOUT = OFF_WIN + 25 * MiB;
constexpr size_t OFF_WPG = OFF_WOUT + 8 * MiB;
constexpr size_t OFF_WPLE = OFF_WPG + 8 * MiB;
constexpr size_t OFF_WPOOL = OFF_WPLE + 1 * MiB;
constexpr size_t OFF_VD = OFF_WPOOL + MiB / 2;
constexpr size_t OFF_BL = OFF_VD + MiB / 2;
constexpr size_t OFF_BS = OFF_BL + 2359296;
constexpr size_t OFF_CTL = 47 * MiB + MiB / 2;
constexpr size_t OFF_RS = OFF_CTL + 65536;
constexpr size_t OFF_BUFA = 48 * MiB;
constexpr size_t OFF_Z = OFF_BUFA + 128 * MiB;
constexpr size_t OFF_ZL = OFF_Z + 384 * MiB;
constexpr size_t OFF_SI = OFF_ZL + 16 * MiB;
constexpr size_t OFF_VF = OFF_SI + 384 * MiB;
constexpr size_t WS_END = OFF_VF + 64 * MiB;
static_assert(OFF_BS + 2 * MiB <= OFF_BUFA, "ws map");
constexpr size_t ARR = (size_t)M * 1024;

namespace pg8 {
constexpr int BM = 256, BK = 64, HALF = 128, HTB = HALF * BK * 2, STAGE_BYTES = 8 * HTB, NXCD = 8, WGM = 8;
__device__ __forceinline__ int lds_byte(int r, int c) { const int st = (r >> 4) * 2 + (c >> 5), rr = r & 15, cc = c & 31, ob = rr * 64 + cc * 2; return st * 1024 + (ob ^ (((ob >> 9) & 1) << 5)); }
__device__ __forceinline__ void stage_rc(int b, int& R, int& C) { const int st = b / 1024, sb = b % 1024, swz = sb ^ (((sb >> 9) & 1) << 5); R = (st >> 1) * 16 + swz / 64; C = (st & 1) * 32 + (swz % 64) / 2; }
__device__ __forceinline__ int perm32(int rho) { const int n = rho >> 4, i = rho & 15; return 8 * (i >> 2) + 4 * n + (i & 3); }
struct Unit { int pm, pn; };
struct StaticOrder {
    int nM, nN, nwg, G, c;
    __device__ void init(int M_, int N_, int G_, int c_) { nM = M_ / BM; nN = N_ / BM; nwg = nM * nN; G = G_; c = c_; }
    __device__ bool next(int i, Unit& u) const {
        const long L = (long)i * G + c; if (L >= nwg) return false;
        int wgid = (int)L; { const int q = nwg / NXCD, r = nwg % NXCD, xcd = wgid % NXCD, off = wgid / NXCD; wgid = (xcd < r ? xcd * (q + 1) : r * (q + 1) + (xcd - r) * q) + off; }
        const int nig = WGM * nN, gid = wgid / nig, fm = gid * WGM, gsz = (nM - fm) < WGM ? (nM - fm) : WGM;
        u.pm = fm + ((wgid % nig) % gsz); u.pn = (wgid % nig) / gsz; return true;
    }
};
}

struct Job {
    const f16* A; const f16* Bt; int N, K, lda, ldb; long a_pn_off;
    int mode, ldc, tps, col_off, z24; long split_stride;
    f16* o16; float* o32; const float* f0; const f16* h0; const f16* h1; const float* xin; float* xsq; int nbj;
};

__device__ __forceinline__ unsigned pkh(float a, float b) { typedef _Float16 h2 __attribute__((ext_vector_type(2))); h2 v; v.x = (f16)a; v.y = (f16)b; return __builtin_bit_cast(unsigned, v); }
__device__ __forceinline__ void st8acc(f16* p, const f32x4& v0, const f32x4& v1) { u32x4 w; w.x = pkh(v0[0], v0[1]); w.y = pkh(v0[2], v0[3]); w.z = pkh(v1[0], v1[1]); w.w = pkh(v1[2], v1[3]); *(u32x4*)p = w; }
__device__ __forceinline__ float sigm(float x) { return __builtin_amdgcn_rcpf(1.0f + __expf(-x)); }

__device__ __forceinline__ void epilogue(const Job& J, const f32x4 (&acc)[2][2][4][2], const pg8::Unit& u, int wr, int wc, int fr, int fq) {
    const int row0 = u.pm * 256 + wr * 64 + fr, ct = wc * 32 + 8 * fq;
    if (J.mode == 0) {
        const int sp = u.pn / J.tps, cn = u.pn - sp * J.tps;
        f16* base = J.o16 + (size_t)sp * J.split_stride;
        const int ld = (J.z24 && u.pn == 24) ? 256 : J.ldc;
        const int col = cn * 256 + J.col_off + ct;
        float rs[2][4];
#pragma unroll
        for (int ai = 0; ai < 2; ++ai)
#pragma unroll
            for (int m = 0; m < 4; ++m) rs[ai][m] = J.f0 ? J.f0[row0 + ai * 128 + m * 16] : 1.0f;
#pragma unroll
        for (int ai = 0; ai < 2; ++ai)
#pragma unroll
            for (int m = 0; m < 4; ++m) { const int row = row0 + ai * 128 + m * 16; f16* rowp = base + (size_t)row * ld + col;
                const float r = J.f0 ? __builtin_amdgcn_rsqf(rs[ai][m] * (1.0f / D) + 1e-6f) : 1.0f;
#pragma unroll
                for (int bj = 0; bj < 2; ++bj) if (bj < J.nbj) st8acc(rowp + bj * 128, acc[ai][bj][m][0] * r, acc[ai][bj][m][1] * r); }
    } else if (J.mode == 1) {
        const int colg = u.pn * 256 + ct;
        f32x4 sc[2][2];
#pragma unroll
        for (int bj = 0; bj < 2; ++bj) { sc[bj][0] = *(const f32x4*)(J.f0 + colg + bj * 128); sc[bj][1] = *(const f32x4*)(J.f0 + colg + bj * 128 + 4); }
#pragma unroll
        for (int ai = 0; ai < 2; ++ai) {
            f16x8 g[4][2];
#pragma unroll
            for (int m = 0; m < 4; ++m)
#pragma unroll
                for (int bj = 0; bj < 2; ++bj) g[m][bj] = *(const f16x8*)(J.h0 + (size_t)(row0 + ai * 128 + m * 16) * 1024 + colg + bj * 128);
#pragma unroll
            for (int m = 0; m < 4; ++m)
#pragma unroll
                for (int bj = 0; bj < 2; ++bj) { const size_t row = (size_t)(row0 + ai * 128 + m * 16);
                    f32x4 a0 = acc[ai][bj][m][0], a1 = acc[ai][bj][m][1];
#pragma unroll
                    for (int j = 0; j < 4; ++j) { const float g0 = (float)g[m][bj][j], g1 = (float)g[m][bj][4 + j]; a0[j] = a0[j] * sc[bj][0][j] * g0 * sigm(g0); a1[j] = a1[j] * sc[bj][1][j] * g1 * sigm(g1); }
                    st8acc(J.o16 + row * 2048 + 1024 + colg + bj * 128, a0, a1); }
        }
    } else if (J.mode == 2) {
        const int colg = u.pn * 256 + ct;
#pragma unroll
        for (int ai = 0; ai < 2; ++ai) {
            f16x8 xh[4][2];
#pragma unroll
            for (int m = 0; m < 4; ++m)
#pragma unroll
                for (int bj = 0; bj < 2; ++bj) xh[m][bj] = *(const f16x8*)(J.h1 + (size_t)(row0 + ai * 128 + m * 16) * 2048 + colg + bj * 128);
#pragma unroll
            for (int m = 0; m < 4; ++m)
#pragma unroll
                for (int bj = 0; bj < 2; ++bj) { const size_t o = (size_t)(row0 + ai * 128 + m * 16) * 2048 + colg + bj * 128;
                    f32x4 x0 = acc[ai][bj][m][0], x1 = acc[ai][bj][m][1];
#pragma unroll
                    for (int j = 0; j < 4; ++j) { x0[j] += (float)xh[m][bj][j]; x1[j] += (float)xh[m][bj][4 + j]; }
                    st8acc(J.o16 + o, x0, x1); }
        }
    } else {
        const int colg = u.pn * 256 + ct;
        f32x4 bs[2][2];
#pragma unroll
        for (int bj = 0; bj < 2; ++bj) { bs[bj][0] = *(const f32x4*)(J.f0 + colg + bj * 128); bs[bj][1] = *(const f32x4*)(J.f0 + colg + bj * 128 + 4); }
#pragma unroll
        for (int ai = 0; ai < 2; ++ai)
#pragma unroll
            for (int mh = 0; mh < 2; ++mh) {
                f16x8 pl[2][2], xm[2][2];
#pragma unroll
                for (int mm = 0; mm < 2; ++mm)
#pragma unroll
                    for (int bj = 0; bj < 2; ++bj) { const size_t o = (size_t)(row0 + ai * 128 + (mh * 2 + mm) * 16) * 2048 + colg + bj * 128;
                        pl[mm][bj] = *(const f16x8*)(J.h0 + o); xm[mm][bj] = *(const f16x8*)(J.h1 + o); }
#pragma unroll
                for (int mm = 0; mm < 2; ++mm) {
                    const int m = mh * 2 + mm, row = row0 + ai * 128 + m * 16; float q = 0.f;
#pragma unroll
                    for (int bj = 0; bj < 2; ++bj) { const size_t o = (size_t)row * 2048 + colg + bj * 128;
                        f32x4 x0, x1;
                        const f32x4 a0 = acc[ai][bj][m][0] + bs[bj][0], a1 = acc[ai][bj][m][1] + bs[bj][1];
#pragma unroll
                        for (int j = 0; j < 4; ++j) { x0[j] = (float)xm[mm][bj][j] + sigm(a0[j]) * (float)pl[mm][bj][j]; x1[j] = (float)xm[mm][bj][4 + j] + sigm(a1[j]) * (float)pl[mm][bj][4 + j]; }
                        if (J.o32) { *(f32x4*)(J.o32 + o) = x0; *(f32x4*)(J.o32 + o + 4) = x1; } else st8acc(J.o16 + o, x0, x1);
                        q += ((x0[0] * x0[0] + x0[1] * x0[1]) + (x0[2] * x0[2] + x0[3] * x0[3])) + ((x1[0] * x1[0] + x1[1] * x1[1]) + (x1[2] * x1[2] + x1[3] * x1[3])); }
                    q += __shfl_xor(q, 16); q += __shfl_xor(q, 32);
                    if (fq == 0) atomicAdd(J.xsq + row, q);
                }
            }
    }
}

__device__ __forceinline__ void gemm_phase(LAS unsigned char* lds, const Job& g, const pg8::StaticOrder& S) {
    using namespace pg8;
    const int tid = threadIdx.x, wid = __builtin_amdgcn_readfirstlane(tid >> 6), lane = tid & 63, wr = wid >> 2, wc = wid & 3, fr = lane & 15, fq = lane >> 4;
    const int K = g.K, nt = K / BK;
    unsigned voffA[2], voffB[2];
#pragma unroll
    for (int i = 0; i < 2; ++i) { int R, C; stage_rc(tid * 16 + i * 8192, R, C); const int Rb = (R & ~31) + perm32(R & 31);
        voffA[i] = (unsigned)(R * g.lda + C) * 2u; voffB[i] = (unsigned)(Rb * g.ldb + C) * 2u; }
    const size_t kstep = (size_t)(BK * 2);
    const size_t hA = (size_t)HALF * g.lda * 2, hB = (size_t)HALF * g.ldb * 2;
    const size_t tA = 2 * hA, tB = 2 * hB;
    const unsigned ldsw = (unsigned)wid * 1024u;
    const int aoff = lds_byte(wr * 64 + fr, fq * 8), boff = lds_byte(wc * 32 + fr, fq * 8);
#define PG8_SA(b, h) (((b) * 2 + (h)) * HTB)
#define PG8_SB(b, h) ((4 + (b) * 2 + (h)) * HTB)
#define PG8_STAGE(bufoff, gbase, voff) do { _Pragma("unroll") for (int _i = 0; _i < 2; ++_i) \
        __builtin_amdgcn_global_load_lds((const unsigned*)((const char*)(gbase) + (voff)[_i]), (LAS unsigned*)(lds + (bufoff) + ldsw + _i * 8192), 16, 0, 0); } while (0)
#define PG8_LDA(dst, b, h) do { _Pragma("unroll") for (int m = 0; m < 4; ++m) _Pragma("unroll") for (int k = 0; k < 2; ++k) dst[m][k] = *(const LAS f16x8*)(lds + PG8_SA(b, h) + aoff + m * 2048 + k * 1024); } while (0)
#define PG8_LDB(dst, b, h) do { _Pragma("unroll") for (int n = 0; n < 2; ++n) _Pragma("unroll") for (int k = 0; k < 2; ++k) dst[n][k] = *(const LAS f16x8*)(lds + PG8_SB(b, h) + boff + n * 2048 + k * 1024); } while (0)
#define PG8_MMA(ai, bj, At, Bt) do { __builtin_amdgcn_s_setprio(1); _Pragma("unroll") for (int m = 0; m < 4; ++m) _Pragma("unroll") for (int n = 0; n < 2; ++n) _Pragma("unroll") for (int k = 0; k < 2; ++k) \
        acc[ai][bj][m][n] = __builtin_amdgcn_mfma_f32_16x16x32_f16(Bt[n][k], At[m][k], acc[ai][bj][m][n], 0, 0, 0); __builtin_amdgcn_s_setprio(0); } while (0)
#define PG8_WAIT_V(n) asm volatile("s_waitcnt vmcnt(" #n ")" ::: "memory")
#define PG8_WAIT_L(n) asm volatile("s_waitcnt lgkmcnt(" #n ")" ::: "memory")
#define PG8_BAR __builtin_amdgcn_s_barrier()
#define PG8_SCHED __builtin_amdgcn_sched_barrier(0)
    Unit cur, nxt; int ui = 0;
    if (!S.next(0, cur)) return;
    f32x4 acc[2][2][4][2];
#pragma unroll
    for (int a = 0; a < 2; ++a)
#pragma unroll
        for (int b = 0; b < 2; ++b)
#pragma unroll
            for (int m = 0; m < 4; ++m)
#pragma unroll
                for (int n = 0; n < 2; ++n) acc[a][b][m][n] = (f32x4){0.f, 0.f, 0.f, 0.f};
    f16x8 At[4][2], B0[2][2], B1[2][2];
    const char* cA = (const char*)g.A + (size_t)cur.pm * tA + (size_t)cur.pn * g.a_pn_off; const char* cB = (const char*)g.Bt + (size_t)cur.pn * tB;
    PG8_STAGE(PG8_SB(0, 0), cB, voffB); PG8_STAGE(PG8_SA(0, 0), cA, voffA); PG8_STAGE(PG8_SB(0, 1), cB + hB, voffB); PG8_STAGE(PG8_SA(0, 1), cA + hA, voffA);
    if (wr == 1) PG8_BAR;
    PG8_WAIT_V(4); PG8_BAR;
    PG8_STAGE(PG8_SB(1, 0), cB + kstep, voffB); PG8_STAGE(PG8_SA(1, 0), cA + kstep, voffA); PG8_STAGE(PG8_SB(1, 1), cB + hB + kstep, voffB);
    PG8_WAIT_V(6); PG8_BAR;
    for (;;) {
        const bool has_next = S.next(ui + 1, nxt);
        const char* nA = has_next ? (const char*)g.A + (size_t)nxt.pm * tA + (size_t)nxt.pn * g.a_pn_off : cA; const char* nB = has_next ? (const char*)g.Bt + (size_t)nxt.pn * tB : cB;
        for (int t = 0; t < nt; t += 2) {
            const bool last = (t == nt - 2);
            const char* a1 = cA + (size_t)(t + 1) * kstep;
            const char* a2 = last ? nA : cA + (size_t)(t + 2) * kstep; const char* b2 = last ? nB : cB + (size_t)(t + 2) * kstep;
            const char* a3 = a2 + kstep; const char* b3 = b2 + kstep;
            PG8_LDB(B0, 0, 0); PG8_SCHED; PG8_LDA(At, 0, 0); PG8_STAGE(PG8_SA(1, 1), a1 + hA, voffA);
            PG8_WAIT_L(8); PG8_BAR; PG8_WAIT_L(0); PG8_MMA(0, 0, At, B0); PG8_BAR; PG8_SCHED;
            PG8_LDB(B1, 0, 1); PG8_STAGE(PG8_SB(0, 0), b2, voffB);
            PG8_BAR; PG8_WAIT_L(0); PG8_MMA(0, 1, At, B1); PG8_BAR;
            PG8_LDA(At, 0, 1); PG8_STAGE(PG8_SA(0, 0), a2, voffA);
            PG8_BAR; PG8_WAIT_L(0); PG8_MMA(1, 0, At, B0); PG8_BAR; PG8_SCHED;
            PG8_STAGE(PG8_SB(0, 1), b2 + hB, voffB);
            PG8_WAIT_V(6); PG8_BAR; PG8_MMA(1, 1, At, B1); PG8_BAR;
            PG8_LDB(B0, 1, 0); PG8_SCHED; PG8_LDA(At, 1, 0); PG8_STAGE(PG8_SA(0, 1), a2 + hA, voffA);
            PG8_WAIT_L(8); PG8_BAR; PG8_WAIT_L(0); PG8_MMA(0, 0, At, B0); PG8_BAR; PG8_SCHED;
            PG8_LDB(B1, 1, 1); PG8_STAGE(PG8_SB(1, 0), b3, voffB);
            PG8_BAR; PG8_WAIT_L(0); PG8_MMA(0, 1, At, B1); PG8_BAR;
            PG8_LDA(At, 1, 1); PG8_STAGE(PG8_SA(1, 0), a3, voffA);
            PG8_BAR; PG8_WAIT_L(0); PG8_MMA(1, 0, At, B0); PG8_BAR; PG8_SCHED;
            PG8_STAGE(PG8_SB(1, 1), b3 + hB, voffB);
            PG8_WAIT_V(6); PG8_BAR; PG8_MMA(1, 1, At, B1); PG8_BAR;
        }
        epilogue(g, acc, cur, wr, wc, fr, fq);
        if (!has_next) break;
#pragma unroll
        for (int a = 0; a < 2; ++a)
#pragma unroll
            for (int b = 0; b < 2; ++b)
#pragma unroll
                for (int m = 0; m < 4; ++m)
#pragma unroll
                    for (int n = 0; n < 2; ++n) acc[a][b][m][n] = (f32x4){0.f, 0.f, 0.f, 0.f};
        cur = nxt; cA = nA; cB = nB; ++ui;
    }
    PG8_WAIT_V(0);
    if (wr == 0) PG8_BAR;
    PG8_BAR;
#undef PG8_SA
#undef PG8_SB
#undef PG8_STAGE
#undef PG8_LDA
#undef PG8_LDB
#undef PG8_MMA
#undef PG8_WAIT_V
#undef PG8_WAIT_L
#undef PG8_BAR
#undef PG8_SCHED
}

#define LDS_WAIT() asm volatile("s_waitcnt lgkmcnt(0)" ::: "memory")
template <int CTRL> __device__ __forceinline__ float dppf(float x) { return __builtin_bit_cast(float, __builtin_amdgcn_update_dpp(0, __builtin_bit_cast(int, x), CTRL, 0xF, 0xF, true)); }
__device__ __forceinline__ float sum8(float x) { x += dppf<0xB1>(x); x += dppf<0x4E>(x); x += dppf<0x141>(x); return x; }
__device__ __forceinline__ float sum16(float x) { x = sum8(x); x += dppf<0x140>(x); return x; }
__device__ __forceinline__ float wave_sum(float v) {
#pragma unroll
    for (int o = 1; o < 64; o <<= 1) v += __shfl_xor(v, o);
    return v;
}
__device__ __forceinline__ void ld8(const f16* p, float (&o)[8]) { const f16x8 h = *(const f16x8*)p;
#pragma unroll
    for (int i = 0; i < 8; ++i) o[i] = (float)h[i]; }
__device__ __forceinline__ void cv8(const f16x8& h, float (&o)[8]) {
#pragma unroll
    for (int i = 0; i < 8; ++i) o[i] = (float)h[i]; }
__device__ __forceinline__ void ld8nt(const f16* p, float (&o)[8]) { const f16x8 h = __builtin_nontemporal_load((const f16x8*)p);
#pragma unroll
    for (int i = 0; i < 8; ++i) o[i] = (float)h[i]; }
__device__ __forceinline__ void ldf8nt(const float* p, float (&o)[8]) { const f32x4 a = __builtin_nontemporal_load((const f32x4*)p), b = __builtin_nontemporal_load((const f32x4*)(p + 4));
#pragma unroll
    for (int i = 0; i < 4; ++i) { o[i] = a[i]; o[4 + i] = b[i]; } }
__device__ __forceinline__ void st8(f16* p, const float (&v)[8]) { u32x4 w; w.x = pkh(v[0], v[1]); w.y = pkh(v[2], v[3]); w.z = pkh(v[4], v[5]); w.w = pkh(v[6], v[7]); *(u32x4*)p = w; }
__device__ __forceinline__ void ldf8(const float* p, float (&o)[8]) { const f32x4 a = *(const f32x4*)p, b = *(const f32x4*)(p + 4);
#pragma unroll
    for (int i = 0; i < 4; ++i) { o[i] = a[i]; o[4 + i] = b[i]; } }

__device__ __forceinline__ void tr_item(const float* src, int ld_src, int k0, int c0, f16* dst, int ld_dst, int r0, int kc0, LAS float* scr, int lane, const float* gk) {
#pragma unroll 16
    for (int i = 0; i < 32; ++i) { const int kk = 2 * i + (lane >> 5); scr[kk * 33 + (lane & 31)] = __builtin_nontemporal_load(src + (size_t)(k0 + kk) * ld_src + c0 + (lane & 31)) * (gk ? gk[k0 + kk] : 1.0f); }
    LDS_WAIT();
    const int c = lane & 7;
#pragma unroll
    for (int j = 0; j < 4; ++j) { const int n = (lane >> 3) + 8 * j; const LAS float* s = scr + (8 * c) * 33 + n;
        u32x4 o; o.x = pkh(s[0 * 33], s[1 * 33]); o.y = pkh(s[2 * 33], s[3 * 33]); o.z = pkh(s[4 * 33], s[5 * 33]); o.w = pkh(s[6 * 33], s[7 * 33]);
        *(u32x4*)(dst + (size_t)(r0 + n) * ld_dst + kc0 + 8 * c) = o; }
    LDS_WAIT();
}


#define XB_TMO      128
#define XB_XCNT(j)  (256  + 64 * (j))
#define XB_XSUB(j)  (1280 + 64 * (j))
#define XB_XGEN(j)  (2304 + 64 * (j))
#define XB_TOP      3328
#define XB_TOPGEN   3392
#define XCD_BAR_WORDS 3456
#define XB_SPIN_CAP (1u << 22)
__device__ __forceinline__ unsigned xb_ld(unsigned* p)              { return __hip_atomic_load(p, __ATOMIC_RELAXED, __HIP_MEMORY_SCOPE_AGENT); }
__device__ __forceinline__ unsigned xb_add(unsigned* p, unsigned v) { return __hip_atomic_fetch_add(p, v, __ATOMIC_RELAXED, __HIP_MEMORY_SCOPE_AGENT); }
__device__ __forceinline__ unsigned xb_xcc_id() { return (unsigned)__builtin_amdgcn_s_getreg((3 << 11) | 20) & 0xFu; }
#define XB_SPIN(cond, bar) do { unsigned _sp = 0; while (cond) { __builtin_amdgcn_s_sleep(1); \
    if ((++_sp & 255u) == 0u) { if (xb_ld(&(bar)[XB_TMO])) break; if (_sp > XB_SPIN_CAP) { atomicAdd(&(bar)[XB_TMO], 1u); break; } } } } while (0)
__device__ __forceinline__ void xcd_barrier_complete(unsigned* bar, unsigned x, unsigned& nloc, unsigned& nx) {
    const unsigned G = gridDim.x * gridDim.y * gridDim.z;
    unsigned sum, cnt, mine, sp = 0u;
    for (;;) {
        sum = 0u; cnt = 0u; mine = 0u;
#pragma unroll
        for (unsigned j = 0; j < 16; ++j) { const unsigned c = xb_ld(&bar[XB_XCNT(j)]); sum += c; cnt += (c > 0u) ? 1u : 0u; mine = (j == x) ? c : mine; }
        if (sum == G) break;
        __builtin_amdgcn_s_sleep(1);
        if ((++sp & 255u) == 0u) { if (xb_ld(&bar[XB_TMO])) break; if (sp > XB_SPIN_CAP) { atomicAdd(&bar[XB_TMO], 1u); break; } }
    }
    nloc = mine > 0u ? mine : 1u; nx = cnt > 0u ? cnt : 1u;
}
__device__ __forceinline__ void xcd_barrier(unsigned* bar, volatile LAS unsigned* st) {
    asm volatile("s_waitcnt vmcnt(0)" ::: "memory");
    __syncthreads();
    if (threadIdx.x == 0) {
        const unsigned x = xb_xcc_id();
        __builtin_amdgcn_s_waitcnt(0);
        unsigned nloc = st[0], nx = st[1];
        if (nloc == 0u) { xcd_barrier_complete(bar, x, nloc, nx); st[0] = nloc; st[1] = nx; }
        const unsigned old = xb_add(&bar[XB_XSUB(x)], 1u);
        const unsigned gen = old / nloc;
        if (old + 1u == (gen + 1u) * nloc) {
            __builtin_amdgcn_fence(__ATOMIC_RELEASE, "agent");
            asm volatile("s_waitcnt vmcnt(0)" ::: "memory");
            const unsigned og = xb_add(&bar[XB_TOP], 1u);
            const unsigned tg = og / nx;
            if (og + 1u == (tg + 1u) * nx) xb_add(&bar[XB_TOPGEN], 1u);
            else XB_SPIN(xb_ld(&bar[XB_TOPGEN]) == tg, bar);
            __builtin_amdgcn_fence(__ATOMIC_ACQUIRE, "agent");
            xb_add(&bar[XB_XGEN(x)], 1u);
            asm volatile("s_waitcnt vmcnt(0)" ::: "memory");
        } else {
            XB_SPIN(xb_ld(&bar[XB_XGEN(x)]) == gen, bar);
            __builtin_amdgcn_fence(__ATOMIC_ACQUIRE, "agent");
            asm volatile("s_waitcnt vmcnt(0)" ::: "memory");
        }
    }
    __syncthreads();
}

struct Params { const float* in[24]; float* out; unsigned char* ws; };
typedef const Params __attribute__((address_space(4)))* KP;
__device__ __forceinline__ KP kparams() { auto kp = __builtin_amdgcn_kernarg_segment_ptr(); asm volatile("" : "+s"(kp)); return (KP)kp; }
enum { I_X = 0, I_P, I_NORMG, I_WIN, I_MU, I_W0, I_WUP, I_A0, I_AUP, I_V0, I_VDOWN, I_VUP, I_KK, I_KA, I_RK, I_LNW, I_LNB, I_WPOOL, I_PSCALE, I_WOUT, I_WPLE, I_WPG, I_BPG, I_FG };


#define WinT ((f16*)(ws + OFF_WIN))
#define WoutT ((f16*)(ws + OFF_WOUT))
#define WpgT ((f16*)(ws + OFF_WPG))
#define WpleT ((f16*)(ws + OFF_WPLE))
#define WpoolT ((f16*)(ws + OFF_WPOOL))
#define VdT ((f16*)(ws + OFF_VD))
#define BLT ((f16*)(ws + OFF_BL))
#define BS ((float*)(ws + OFF_BS))
#define BUFA ((f16*)(ws + OFF_BUFA))
#define Z ((f16*)(ws + OFF_Z))
#define ZL ((f16*)(ws + OFF_ZL))
#define SI ((f16*)(ws + OFF_SI))
#define VF ((f16*)(ws + OFF_VF))
#define RS ((float*)(ws + OFF_RS))
#define AL SI
#define D16 (SI + ARR)
#define Y16 (SI)
#define X16 Z
#define PL (Z + 4 * ARR)
#define P16 ZL
#define XO (kp->out)
#define XH ((f16*)kp->out)
#define XF ((float*)(ws + OFF_SI))
#define PHASE_PTRS() KP kp = kparams(); unsigned char* ws = kp->ws; int tid = threadIdx.x; asm volatile("" : "+v"(tid)); \
    const int lane = tid & 63, wid = __builtin_amdgcn_readfirstlane(tid >> 6), G = gridDim.x, gw = blockIdx.x * 8 + wid, NGW = G * 8; (void)lane; (void)gw; (void)NGW; (void)ws

__device__ __forceinline__ void rms_row(const float* xrow, const float* g, f16* o16, float* o32, int lane) {
    const f32x4* xr = (const f32x4*)xrow + lane;
    f32x4 v[8]; float s = 0.f;
#pragma unroll
    for (int j = 0; j < 8; ++j) { v[j] = xr[64 * j]; s += (v[j][0] * v[j][0] + v[j][1] * v[j][1]) + (v[j][2] * v[j][2] + v[j][3] * v[j][3]); }
    const float rstd = 1.0f / sqrtf(wave_sum(s) * (1.0f / D) + 1e-6f);
#pragma unroll
    for (int j = 0; j < 8; ++j) { const f32x4 gv = ((const f32x4*)g)[lane + 64 * j]; const f32x4 y = v[j] * rstd * gv;
        if (o16) { unsigned long long w = (unsigned long long)pkh(y[0], y[1]) | ((unsigned long long)pkh(y[2], y[3]) << 32); ((unsigned long long*)o16)[lane + 64 * j] = w; }
        else ((f32x4*)o32)[lane + 64 * j] = y; }
}

__global__ void __launch_bounds__(512, 2) fwd_megakernel(Params P) {
    extern __shared__ __attribute__((aligned(16))) unsigned char smem[];
    LAS unsigned char* lds = (LAS unsigned char*)smem;
    cg::grid_group grid = cg::this_grid();
    volatile LAS unsigned* bst = (volatile LAS unsigned*)(lds + 131072);
    { KP kp0 = kparams(); unsigned* bar0 = (unsigned*)(kp0->ws + OFF_CTL);
      if (threadIdx.x == 0) { bst[0] = 0u; bst[1] = 0u; }
      if (blockIdx.x == 0) for (int i = threadIdx.x; i < XCD_BAR_WORDS; i += 512) __hip_atomic_store(&bar0[i], 0u, __ATOMIC_RELAXED, __HIP_MEMORY_SCOPE_AGENT);
      __threadfence(); }
#pragma unroll 1
    for (int L = 0; L < 4; ++L) {
#pragma unroll 1
        for (int st = 0; st < 10; ++st) {
            int nj = 0;
            if (st == 0 && L > 0) continue;
            if (st == 0 || st == 2) {
                PHASE_PTRS();
                LAS float* scr = (LAS float*)(lds + wid * 8704);
                const int Lin = (st == 0) ? 0 : L + 1;
                const bool do_rest = (st == 2);
                const float* w_in = kp->in[I_WIN] + (size_t)(Lin < 4 ? Lin : 0) * 2048 * 6272;
                const float* gin = kp->in[I_NORMG] + (size_t)(Lin < 4 ? Lin : 0) * D;
                const float* w_out = kp->in[I_WOUT] + (size_t)L * 2048 * 2048;
                const float* w_pg = kp->in[I_WPG] + (size_t)L * 2048 * 2048;
                const float* w_ple = kp->in[I_WPLE] + (size_t)L * 256 * 2048;
                const float* w_pool = kp->in[I_WPOOL] + (size_t)L * 4 * 256 * 256;
                constexpr int N_IN_ITEMS = 32 * 196, N_SQ = 32 * 64, N_PLE = 4 * 64, N_POOL = 4 * 4 * 8;
                constexpr int N_LORA = 64;
                constexpr int NITEMS = N_IN_ITEMS + 2 * N_SQ + N_PLE + N_POOL + N_LORA;
                const float* w_upc = kp->in[I_WUP] + (size_t)L * 64 * 1024; const float* a_upc = kp->in[I_AUP] + (size_t)L * 64 * 1024;
                const int it_lo = (Lin < 4) ? 0 : N_IN_ITEMS, it_hi = do_rest ? NITEMS : N_IN_ITEMS;
                for (int it = it_lo + gw; it < it_hi; it += NGW) {
                    int r = it; const float* src; f16* dst; int ld_src, ld_dst, k0, c0, r0, kc_add = 0; const float* gk = nullptr;
                    if (r < N_IN_ITEMS) { const int kb = r / 196, nb = r % 196, c = nb * 32; r0 = (c < 3072) ? c : (c < 3200 ? c + 3072 : c - 128);
                        src = w_in; ld_src = 6272; k0 = kb * 64; c0 = c; dst = WinT; ld_dst = 2048; gk = gin; }
                    else if (r < N_IN_ITEMS + 2 * N_SQ) { r -= N_IN_ITEMS; const bool second = r >= N_SQ; if (second) r -= N_SQ; const int kb = r / 64, nb = r % 64;
                        src = second ? w_pg : w_out; ld_src = 2048; k0 = kb * 64; c0 = nb * 32; dst = second ? WpgT : WoutT; ld_dst = 2048; r0 = nb * 32; }
                    else if (r < N_IN_ITEMS + 2 * N_SQ + N_PLE) { r -= N_IN_ITEMS + 2 * N_SQ; const int kb = r / 64, nb = r % 64;
                        src = w_ple; ld_src = 2048; k0 = kb * 64; c0 = nb * 32; dst = WpleT; ld_dst = 256; r0 = nb * 32; }
                    else if (r < N_IN_ITEMS + 2 * N_SQ + N_PLE + N_POOL) { r -= N_IN_ITEMS + 2 * N_SQ + N_PLE; const int gq = r / 32, rr = r % 32, kb = rr / 8, nb = rr % 8;
                        src = w_pool + (size_t)gq * 65536; ld_src = 256; k0 = kb * 64; c0 = nb * 32; dst = WpoolT + (size_t)gq * 65536; ld_dst = 256; r0 = nb * 32; }
                    else { r -= N_IN_ITEMS + 2 * N_SQ + N_PLE + N_POOL; const bool second = r >= 32; const int nb = r & 31;
                        src = second ? a_upc : w_upc; ld_src = 1024; k0 = 0; c0 = nb * 32; dst = BLT; ld_dst = 256; r0 = (second ? 1024 : 0) + nb * 32; kc_add = second ? 64 : 0; }
                    tr_item(src, ld_src, k0, c0, dst, ld_dst, r0, k0 + kc_add, scr, lane, gk);
                }
                if (st == 0) {
                    for (int i = gw * 64 + lane; i < 128 * 2048 / 8; i += NGW * 64) *(u32x4*)(WinT + (size_t)6272 * 2048 + (size_t)i * 8) = (u32x4){0u, 0u, 0u, 0u};
                    for (int i = gw * 64 + lane; i < 3072 * 256 / 8; i += NGW * 64) *(u32x4*)(BLT + (size_t)i * 8) = (u32x4){0u, 0u, 0u, 0u};
                    for (int i = gw * 64 + lane; i < 256 * 1024 / 8; i += NGW * 64) *(u32x4*)(VdT + (size_t)i * 8) = (u32x4){0u, 0u, 0u, 0u};
                    const float* xin = kp->in[I_X];
                    for (int m = gw; m < M; m += NGW) {
                        const f32x4* xr = (const f32x4*)(xin + (size_t)m * D) + lane; float ssq = 0.f;
#pragma unroll
                        for (int j = 0; j < 8; ++j) { const f32x4 v = __builtin_nontemporal_load(xr + 64 * j); ssq += (v[0] * v[0] + v[1] * v[1]) + (v[2] * v[2] + v[3] * v[3]);
                            ((unsigned long long*)(XH + (size_t)m * D))[lane + 64 * j] = (unsigned long long)pkh(v[0], v[1]) | ((unsigned long long)pkh(v[2], v[3]) << 32); }
                        ssq = wave_sum(ssq);
                        if (lane == 0) RS[m] = ssq;
                    }
                } else {
                    for (int i = gw * 64 + lane; i < M; i += NGW * 64) RS[i] = 0.f;
                    if (L > 0) {
                        const float* v_up = kp->in[I_VUP] + (size_t)(L - 1) * 32 * 1024; const float* v_down = kp->in[I_VDOWN] + (size_t)(L - 1) * 1024 * 32;
                        for (int i = gw * 64 + lane; i < 32 * 1024; i += NGW * 64) { const int n = i >> 5, k = i & 31; BLT[(size_t)(2048 + n) * 256 + 128 + k] = (f16)v_up[k * 1024 + n]; }
                        for (int i = gw * 64 + lane; i < 32 * 1024; i += NGW * 64) { const int n = i >> 10, k = i & 1023; VdT[(size_t)n * 1024 + k] = (f16)v_down[k * 32 + n]; }
                    }
                }
            }
            if (st == 0) { }
            else if (st == 1) { nj = 1; }
            else if (st == 2) {
                PHASE_PTRS();
                const float* mu = kp->in[I_MU] + (size_t)L * 3200;
                const f16* Zv = Z + 2 * ARR; const f16* Zu = Z + 4 * ARR;
                for (int it = gw; it < 2048; it += NGW) {
                    const int ms = (it >> 1) * 32, hf = it & 1, c0 = hf * 512 + lane * 8, t0 = ms & (T - 1);
                    const int win = 2 << (c0 >> 8);
                    float sw[8], vprev[8], muv[8];
#pragma unroll
                    for (int i = 0; i < 8; ++i) { sw[i] = 0.f; vprev[i] = 0.f; }
                    ldf8(mu + 2048 + c0, muv);
                    if (t0 > 0) {
#pragma unroll
                        for (int q = 1; q < 16; ++q) if (q < win) { float pv[8]; ld8(Zu + (size_t)(ms - q) * 1024 + c0, pv);
#pragma unroll
                            for (int i = 0; i < 8; ++i) sw[i] += pv[i]; }
                        if (L > 0) ld8(Zv + (size_t)(ms - 1) * 1024 + c0, vprev);
                    }
#pragma unroll 4
                    for (int m = ms; m < ms + 32; ++m) {
                        const int t = t0 + (m - ms); const size_t o = (size_t)m * 1024 + c0;
                        float cur[8], od[8]; ld8(Zu + o, cur);
                        const int nw = (t + 1 < win) ? (t + 1) : win; const float inv = __builtin_amdgcn_rcpf((float)nw);
#pragma unroll
                        for (int i = 0; i < 8; ++i) { sw[i] += cur[i]; od[i] = sw[i] * inv - cur[i]; }
                        st8(D16 + o, od);
                        if (t - win + 1 >= 0) { float old[8]; ld8(Zu + (size_t)(m - win + 1) * 1024 + c0, old);
#pragma unroll
                            for (int i = 0; i < 8; ++i) sw[i] -= old[i]; }
                        if (L > 0) { float vr[8], ov[8]; ld8(Zv + o, vr);
#pragma unroll
                            for (int i = 0; i < 8; ++i) { ov[i] = vr[i] + (vprev[i] - vr[i]) * muv[i]; vprev[i] = vr[i]; }
                            st8(SI + 2 * ARR + o, ov); }
                    }
                    const int ma = ms + 16 * hf;
                    { const int c = (lane & 15) * 8, tsub = lane >> 4; float mv[8]; ldf8(mu + 3072 + c, mv);
                      f16x8 cu[4], pv[4];
#pragma unroll
                      for (int i = 0; i < 4; ++i) { const int m = ma + 4 * i + tsub; cu[i] = *(const f16x8*)(ZL + (size_t)m * 256 + c);
                          if ((m & (T - 1)) > 0) pv[i] = *(const f16x8*)(ZL + (size_t)(m - 1) * 256 + c); else pv[i] = (f16x8)(0); }
#pragma unroll
                      for (int i = 0; i < 4; ++i) { const int m = ma + 4 * i + tsub; float o[8];
#pragma unroll
                          for (int e8 = 0; e8 < 8; ++e8) { const float cur = (float)cu[i][e8], z = cur + ((float)pv[i][e8] - cur) * mv[e8];
                              if (c < 64) { const float e = __expf(2.0f * z); o[e8] = 1.0f - 2.0f * __builtin_amdgcn_rcpf(e + 1.0f); } else o[e8] = z; }
                          st8(AL + (size_t)m * 256 + c, o); }
                      if (L == 0) {
#pragma unroll
                          for (int i = 0; i < 4; ++i) { const int idx = i * 64 + lane; *(u32x4*)(AL + (size_t)(ma + (idx >> 4)) * 256 + 128 + (idx & 15) * 8) = (u32x4){0u, 0u, 0u, 0u}; } }
                    }
                }
            } else if (st == 3) { nj = 2; }
            else if (st == 4) { if (L == 0) continue; nj = 1; }
            else if (st == 5) { continue; }
            else if (st == 6) {
                PHASE_PTRS();
                typedef float f32x2 __attribute__((ext_vector_type(2)));
                const int rg = lane >> 3, kq = lane & 7;
                for (int item = blockIdx.x; item < 256; item += G) {
                    const int bh = item >> 1, half = item & 1, b = bh >> 4, h = bh & 15;
                    const size_t m0 = (size_t)b * T;
                    if (wid >= 4) {
                        const int x = tid - 256, tl = x >> 3, seg = x & 7, c0 = h * 64 + seg * 8;
                        const float* mu = kp->in[I_MU] + (size_t)L * 3200;
                        float mur[8], muk[8], muv[8], w0v[8], a0v[8], v0v[8], kkp[8], kap[8], rkp[8];
                        ldf8(mu + c0, mur); ldf8(mu + 1024 + c0, muk); ldf8(mu + 2048 + c0, muv);
                        ldf8(kp->in[I_W0] + (size_t)L * 1024 + c0, w0v); ldf8(kp->in[I_A0] + (size_t)L * 1024 + c0, a0v);
                        ldf8(kp->in[I_V0] + (size_t)(L > 0 ? L - 1 : 0) * 1024 + c0, v0v);
                        ldf8(kp->in[I_KK] + (size_t)L * 1024 + c0, kkp); ldf8(kp->in[I_KA] + (size_t)L * 1024 + c0, kap); ldf8(kp->in[I_RK] + (size_t)L * 1024 + c0, rkp);
                        const f16* Zr = Z; const f16* Zk = Z + ARR; const f16* Zv = Z + 2 * ARR;
                        const size_t gbase = (m0 + tl) * 1024 + c0;
                        const unsigned loff = (unsigned)(tl * 1280 + seg * 32);
                        constexpr int NC = T / 32;
                        f16x8 q[9];
#pragma unroll
                        for (int i = 0; i < 9; ++i) q[i] = (f16x8)(0);
#define FS_LOAD(ch) do { const size_t _o = gbase + (size_t)(ch) * 32 * 1024; const bool _first = ((ch) == 0 && tl == 0); \
        q[0] = *(const f16x8*)(Zr + _o); q[2] = *(const f16x8*)(Zk + _o); q[4] = *(const f16x8*)(SI + 3 * ARR + _o); q[5] = *(const f16x8*)(SI + 4 * ARR + _o); \
        if (!_first) { q[1] = *(const f16x8*)(Zr + _o - 1024); q[3] = *(const f16x8*)(Zk + _o - 1024); } else { q[1] = (f16x8)(0); q[3] = (f16x8)(0); } \
        if (L == 0) { q[6] = *(const f16x8*)(Zv + _o); if (!_first) q[7] = *(const f16x8*)(Zv + _o - 1024); else q[7] = (f16x8)(0); } \
        else { q[6] = *(const f16x8*)(SI + 2 * ARR + _o); q[7] = *(const f16x8*)(SI + 5 * ARR + _o); q[8] = *(const f16x8*)(VF + _o); } } while (0)
                        FS_LOAD(0);
#pragma unroll 1
                        for (int c = 0; c <= NC; ++c) {
                            if (c < NC) {
                                float rr[8], rp[8], kr[8], kq8[8], lw[8], la[8], vv[8];
                                cv8(q[0], rr); cv8(q[1], rp); cv8(q[2], kr); cv8(q[3], kq8); cv8(q[4], lw); cv8(q[5], la);
                                if (L == 0) { float vr[8], vp[8]; cv8(q[6], vr); cv8(q[7], vp);
#pragma unroll
                                    for (int i = 0; i < 8; ++i) vv[i] = vr[i] + (vp[i] - vr[i]) * muv[i]; }
                                else { float lv[8], vf[8]; cv8(q[6], vv); cv8(q[7], lv); cv8(q[8], vf);
#pragma unroll
                                    for (int i = 0; i < 8; ++i) { const float nu = sigm(v0v[i] + lv[i]); vv[i] = vv[i] + (vf[i] - vv[i]) * nu; } }
                                float ro[8], ko[8], ewv[8], bo[8], nk[8]; float ss = 0.f, bsum = 0.f;
#pragma unroll
                                for (int i = 0; i < 8; ++i) {
                                    const float r = rr[i] + (rp[i] - rr[i]) * mur[i], k = kr[i] + (kq8[i] - kr[i]) * muk[i];
                                    const float ew = sigm(w0v[i] + lw[i]) * 0.6065306597126334f;
                                    ewv[i] = ew;
                                    const float a = sigm(a0v[i] + la[i]);
                                    const float kkv = k * kkp[i]; ss += kkv * kkv; nk[i] = kkv; bo[i] = a;
                                    const float k2 = k * (1.0f + (a - 1.0f) * kap[i]);
                                    ro[i] = r; ko[i] = k2; bsum += r * k2 * rkp[i];
                                }
                                ss = sum8(ss); bsum = sum8(bsum);
                                const float inv = __builtin_amdgcn_rsqf(fmaxf(ss, 1e-24f));
#pragma unroll
                                for (int i = 0; i < 8; ++i) { const float kk = nk[i] * inv; nk[i] = -kk; bo[i] = kk * bo[i]; }
                                float G[8];
#pragma unroll
                                for (int i = 0; i < 8; ++i) G[i] = ewv[i];
#pragma unroll
                                for (int d = 8; d < 64; d <<= 1) {
#pragma unroll
                                    for (int i = 0; i < 8; ++i) { const float up = __shfl_up(G[i], d); if (lane >= d) G[i] += up; } }
                                float ecur[8];
#pragma unroll
                                for (int i = 0; i < 8; ++i) { const float ec = __expf(-G[i]), ei = __expf(G[i]), ep = __expf(ewv[i] - G[i]);
                                    ecur[i] = ec; nk[i] *= ep; ro[i] *= ec; bo[i] *= ei; ko[i] *= ei; }
                                LAS unsigned char* nbuf = lds + (c & 1) * 41984;
                                LAS unsigned char* nb = nbuf + loff;
#define FS_PUT(a, arr) do { *(LAS f32x4*)(nb + (a) * 256) = (f32x4){arr[0], arr[1], arr[2], arr[3]}; *(LAS f32x4*)(nb + (a) * 256 + 16) = (f32x4){arr[4], arr[5], arr[6], arr[7]}; } while (0)
                                FS_PUT(0, nk); FS_PUT(1, bo); FS_PUT(2, ko); FS_PUT(3, ro); FS_PUT(4, vv);
                                if ((lane >> 3) == 7) { LAS unsigned char* gt = nbuf + 40960 + (tl >> 3) * 256 + seg * 32;
                                    *(LAS f32x4*)(gt) = (f32x4){ecur[0], ecur[1], ecur[2], ecur[3]}; *(LAS f32x4*)(gt + 16) = (f32x4){ecur[4], ecur[5], ecur[6], ecur[7]}; }
                                if (half == 0) { const size_t o = gbase + (size_t)c * 32 * 1024;
                                    st8(SI + ARR + o, vv);
                                    if (L == 0) st8(VF + o, vv);
                                    if (seg == 0) BS[(m0 + (size_t)c * 32 + tl) * 16 + h] = bsum; }
                                if (c + 1 < NC) FS_LOAD(c + 1);
                            }
                            __syncthreads();
                        }
                    } else {
                        const int row = half * 32 + wid * 8 + rg;
                        f32x2 Sa = {0.f, 0.f}, Sb = {0.f, 0.f}, Sc = {0.f, 0.f}, Sd = {0.f, 0.f};
                        f16* yout = Y16 + m0 * 1024 + h * 64 + row;
                        __builtin_amdgcn_s_setprio(3);
                        __syncthreads();
#pragma unroll 1
                        for (int c = 0; c < T / 32; ++c) {
                            const LAS unsigned char* buf = lds + (c & 1) * 41984;
                            const LAS unsigned char* pk = buf + kq * 32; const LAS unsigned char* pv = buf + 1024 + row * 4;
#define SCAN_LOAD(dst, dv, stp) do { const LAS unsigned char* _p = pk + (stp) * 1280; \
        dst[0] = *(const LAS f32x4*)(_p); dst[1] = *(const LAS f32x4*)(_p + 16); dst[2] = *(const LAS f32x4*)(_p + 256); dst[3] = *(const LAS f32x4*)(_p + 272); \
        dst[4] = *(const LAS f32x4*)(_p + 512); dst[5] = *(const LAS f32x4*)(_p + 528); dst[6] = *(const LAS f32x4*)(_p + 768); dst[7] = *(const LAS f32x4*)(_p + 784); \
        dv = *(const LAS float*)(pv + (stp) * 1280); } while (0)
                            f32x4 rg2[2][8]; float rv2[2];
                            SCAN_LOAD(rg2[0], rv2[0], 0);
#pragma unroll
                            for (int tt = 0; tt < 32; tt += 8) {
                                float yk = 0.f;
                                const f32x4 ge0 = *(const LAS f32x4*)(pk + 40960 + (tt >> 3) * 256), ge1 = *(const LAS f32x4*)(pk + 40960 + (tt >> 3) * 256 + 16);
#pragma unroll
                                for (int j = 0; j < 8; ++j) {
                                    if (j < 7 || tt + 8 < 32) SCAN_LOAD(rg2[(j + 1) & 1], rv2[(j + 1) & 1], tt + j + 1);
                                    __builtin_amdgcn_sched_barrier(0);
                                    const f32x4 (&cur)[8] = rg2[j & 1]; const float curv = rv2[j & 1];
                                    const f32x2 v2 = {curv, curv};
                                    const f32x2 pa = v2 * cur[4].xy + Sa, pb = v2 * cur[4].zw + Sb, pc = v2 * cur[5].xy + Sc, pd = v2 * cur[5].zw + Sd;
                                    f32x2 t0 = Sa * cur[0].xy; t0 = Sb * cur[0].zw + t0;
                                    f32x2 t1 = Sc * cur[1].xy; t1 = Sd * cur[1].zw + t1;
                                    const f32x2 t = t0 + t1;
                                    float sa = sum8(t.x + t.y);
                                    const f32x2 sa2 = {sa, sa};
                                    Sa = sa2 * cur[2].xy + pa; Sb = sa2 * cur[2].zw + pb; Sc = sa2 * cur[3].xy + pc; Sd = sa2 * cur[3].zw + pd;
                                    f32x2 u0 = Sa * cur[6].xy; u0 = Sb * cur[6].zw + u0;
                                    f32x2 u1 = Sc * cur[7].xy; u1 = Sd * cur[7].zw + u1;
                                    const f32x2 u = u0 + u1;
                                    const float y = sum8(u.x + u.y);
                                    yk = (kq == j) ? y : yk;
                                }
                                Sa *= ge0.xy; Sb *= ge0.zw; Sc *= ge1.xy; Sd *= ge1.zw;
                                yout[(size_t)(c * 32 + tt + kq) * 1024] = (f16)yk;
                            }
                            __syncthreads();
                        }
                        __builtin_amdgcn_s_setprio(0);
                    }
                }
            } else if (st == 7) {
                PHASE_PTRS();
                const f16* Zg = Z + 3 * ARR;
                for (int it = gw; it < 2048; it += NGW) {
                    const int ms = (it >> 1) * 32, c0 = (it & 1) * 512 + lane * 8, head = c0 >> 6;
                    float lnw[8], lnb[8]; ldf8(kp->in[I_LNW] + (size_t)L * 1024 + c0, lnw); ldf8(kp->in[I_LNB] + (size_t)L * 1024 + c0, lnb);
#pragma unroll 2
                    for (int m = ms; m < ms + 32; ++m) {
                        const size_t o = (size_t)m * 1024 + c0;
                        float y[8], v[8], g[8], out[8]; ld8nt(Y16 + o, y); ld8nt(SI + ARR + o, v); ld8nt(Zg + o, g);
                        const float bs = BS[(size_t)m * 16 + head];
                        float s = 0.f;
#pragma unroll
                        for (int i = 0; i < 8; ++i) s += y[i];
                        const float mean = sum8(s) * (1.0f / 64.0f); float q = 0.f;
#pragma unroll
                        for (int i = 0; i < 8; ++i) { y[i] -= mean; q += y[i] * y[i]; }
                        const float rstd = __builtin_amdgcn_rsqf(sum8(q) * (1.0f / 64.0f) + 64e-5f);
#pragma unroll
                        for (int i = 0; i < 8; ++i) out[i] = (y[i] * rstd * lnw[i] + lnb[i] + bs * v[i]) * g[i] * sigm(g[i]);
                        st8(BUFA + (size_t)m * 2048 + c0, out);
                    }
                }
                const float* pL = kp->in[I_P] + (size_t)L * M * 256;
                for (size_t i = (size_t)gw * 64 + lane; i < (size_t)M * 256 / 8; i += (size_t)NGW * 64) { float v[8]; ldf8nt(pL + i * 8, v); st8(P16 + i * 8, v); }
            } else if (st == 8) { nj = 2; }
            else { nj = 1; }

#pragma unroll 1
            for (int j = 0; j < nj; ++j) {
                PHASE_PTRS(); const float* xin = (L == 0) ? kp->in[I_X] : XO;
                Job J; J.a_pn_off = 0; J.z24 = 0; J.tps = 1 << 20; J.col_off = 0; J.split_stride = 0; J.o16 = nullptr; J.o32 = nullptr; J.f0 = nullptr; J.h0 = nullptr; J.h1 = nullptr; J.nbj = 2; J.xin = nullptr; J.xsq = nullptr; J.mode = 0; J.ldc = 0;
                if (st == 1) { J.A = XH; J.Bt = WinT; J.N = NZ; J.K = 2048; J.lda = 2048; J.ldb = 2048; J.o16 = Z; J.ldc = 1024; J.tps = 4; J.split_stride = (long)ARR; J.z24 = 1; J.f0 = RS; }
                else if (st == 3 && j == 0) { J.A = D16; J.Bt = WpoolT; J.N = 1024; J.K = 256; J.lda = 1024; J.ldb = 256; J.a_pn_off = 512; J.mode = 1;
                    J.f0 = kp->in[I_PSCALE] + (size_t)L * 1024; J.h0 = Z + 5 * ARR; J.o16 = BUFA; }
                else if (st == 3 && L > 0) { J.A = SI + 2 * ARR; J.Bt = VdT; J.N = 256; J.K = 1024; J.lda = 1024; J.ldb = 1024; J.o16 = AL; J.ldc = 256; J.col_off = 128; J.nbj = 1; }
                else if (st == 4 || st == 3) { J.A = AL; J.Bt = BLT; J.N = (L > 0) ? 3072 : 2048  ; J.K = 256; J.lda = 256; J.ldb = 256; J.o16 = SI + 3 * ARR; J.ldc = 1024; J.tps = 4; J.split_stride = (long)ARR; }
                else if (st == 8 && j == 0) { J.A = BUFA; J.Bt = WoutT; J.N = 2048; J.K = 2048; J.lda = 2048; J.ldb = 2048; J.mode = 2; J.h1 = XH; J.o16 = X16; }
                else if (st == 8) { J.A = P16; J.Bt = WpleT; J.N = 2048; J.K = 256; J.lda = 256; J.ldb = 256; J.o16 = PL; J.ldc = 2048; }
                else { J.A = X16; J.Bt = WpgT; J.N = 2048; J.K = 2048; J.lda = 2048; J.ldb = 2048; J.mode = 3; J.f0 = kp->in[I_BPG] + (size_t)L * 2048; J.h0 = PL; J.h1 = X16; J.o16 = (L == 3) ? BUFA : XH; J.xsq = RS; }
                pg8::StaticOrder S; S.init(M, J.N, G, (int)blockIdx.x);
                gemm_phase(lds, J, S);
            }
            if (L == 0 && st == 0) {
                grid.sync();
                KP kp0 = kparams(); unsigned* bar0 = (unsigned*)(kp0->ws + OFF_CTL);
                if (threadIdx.x == 0) (void)xb_add(&bar0[XB_XCNT(xb_xcc_id())], 1u);
                __syncthreads();
            } else { KP kpb = kparams(); xcd_barrier((unsigned*)(kpb->ws + OFF_CTL), bst); }
        }
    }
    PHASE_PTRS();
    for (int m = gw; m < M; m += NGW) {
        const float rstd = __builtin_amdgcn_rsqf(RS[m] * (1.0f / D) + 1e-6f);
        const f16* xr = BUFA + (size_t)m * D; const float* fg = kp->in[I_FG]; float* orow = XO + (size_t)m * D;
        f16x8 xv[4];
#pragma unroll
        for (int j = 0; j < 4; ++j) xv[j] = __builtin_nontemporal_load((const f16x8*)(xr + lane * 8 + 512 * j));
#pragma unroll
        for (int j = 0; j < 4; ++j) { const int c = lane * 8 + 512 * j; const f32x4 g0 = *(const f32x4*)(fg + c), g1 = *(const f32x4*)(fg + c + 4); f32x4 o0, o1;
#pragma unroll
            for (int i = 0; i < 4; ++i) { o0[i] = (float)xv[j][i] * rstd * g0[i]; o1[i] = (float)xv[j][4 + i] * rstd * g1[i]; }
            __builtin_nontemporal_store(o0, (f32x4*)(orow + c)); __builtin_nontemporal_store(o1, (f32x4*)(orow + c + 4)); }
    }
}

extern "C" void kernel_launch(void* const* d_in, const int* in_sizes, int n_in, void* d_out, int out_size, void* d_ws, size_t ws_size, hipStream_t stream) {
    constexpr int kDynLds = 131072 + 64;
    static int grid_blocks = 0;
    if (!grid_blocks) {
        if (n_in != 24 || ws_size < WS_END) { fprintf(stderr, "kernel_launch: need 24 inputs and %zu bytes of workspace, got %d / %zu\n", (size_t)WS_END, n_in, ws_size); grid_blocks = -1; return; }
        int dev = 0, cus = 0, per_cu = 0;
        hipGetDevice(&dev);
        hipDeviceGetAttribute(&cus, hipDeviceAttributeMultiprocessorCount, dev);
        hipFuncSetAttribute((const void*)fwd_megakernel, hipFuncAttributeMaxDynamicSharedMemorySize, kDynLds);
        hipOccupancyMaxActiveBlocksPerMultiprocessor(&per_cu, (const void*)fwd_megakernel, 512, kDynLds);
        if (per_cu < 1) per_cu = 1;
        grid_blocks = cus * per_cu;
        if (grid_blocks > 256) grid_blocks = 256;
    }
    if (grid_blocks < 0) return;
    Params p{};
    for (int i = 0; i < 24; ++i) p.in[i] = (const float*)d_in[i];
    p.out = (float*)d_out; p.ws = (unsigned char*)d_ws;
    void* args[] = {&p};
    hipError_t e = hipLaunchCooperativeKernel((const void*)fwd_megakernel, dim3(grid_blocks), dim3(512), args, kDynLds, stream);
    if (e != hipSuccess) fprintf(stderr, "cooperative launch failed: %s (grid %d)\n", hipGetErrorString(e), grid_blocks);
}
```

```cpp
#include <hip/hip_runtime.h>
#include <hip/hip_cooperative_groups.h>
#include <cstdio>
namespace cg = cooperative_groups;

#define LAS __attribute__((address_space(3)))
typedef _Float16 f16;
typedef _Float16 f16x8 __attribute__((ext_vector_type(8)));
typedef _Float16 f16x4 __attribute__((ext_vector_type(4)));
typedef float f32x4 __attribute__((ext_vector_type(4)));
typedef unsigned u32x4 __attribute__((ext_vector_type(4)));

constexpr int NB = 8, T = 4096, M = NB * T, D = 2048, DR = 1024, NZ = 6400;
constexpr size_t MiB = 1u << 20;
constexpr size_t OFF_WIN = 0;
constexpr size_t OFF_WOUT = OFF_WIN + 25 * MiB;
constexpr size_t OFF_WPG = OFF_WOUT + 8 * MiB;
constexpr size_t OFF_WPLE = OFF_WPG + 8 * MiB;
constexpr size_t OFF_WPOOL = OFF_WPLE + 1 * MiB;
constexpr size_t OFF_VD = OFF_WPOOL + MiB / 2;
constexpr size_t OFF_BL = OFF_VD + MiB / 2;
constexpr size_t OFF_BS = OFF_BL + 2359296;
constexpr size_t OFF_CTL = 47 * MiB + MiB / 2;
constexpr size_t OFF_RS = OFF_CTL + 65536;
constexpr size_t OFF_BUFA = 48 * MiB;
constexpr size_t OFF_Z = OFF_BUFA + 128 * MiB;
constexpr size_t OFF_ZL = OFF_Z + 384 * MiB;
constexpr size_t OFF_SI = OFF_ZL + 16 * MiB;
constexpr size_t OFF_VF = OFF_SI + 384 * MiB;
constexpr size_t WS_END = OFF_VF + 64 * MiB;
static_assert(OFF_BS + 2 * MiB <= OFF_BUFA, "ws map");
constexpr size_t ARR = (size_t)M * 1024;

namespace pg8 {
constexpr int BM = 256, BK = 64, HALF = 128, HTB = HALF * BK * 2, STAGE_BYTES = 8 * HTB, NXCD = 8, WGM = 8;
__device__ __forceinline__ int lds_byte(int r, int c) { const int st = (r >> 4) * 2 + (c >> 5), rr = r & 15, cc = c & 31, ob = rr * 64 + cc * 2; return st * 1024 + (ob ^ (((ob >> 9) & 1) << 5)); }
__device__ __forceinline__ void stage_rc(int b, int& R, int& C) { const int st = b / 1024, sb = b % 1024, swz = sb ^ (((sb >> 9) & 1) << 5); R = (st >> 1) * 16 + swz / 64; C = (st & 1) * 32 + (swz % 64) / 2; }
__device__ __forceinline__ int perm32(int rho) { const int n = rho >> 4, i = rho & 15; return 8 * (i >> 2) + 4 * n + (i & 3); }
struct Unit { int pm, pn; };
struct StaticOrder {
    int nM, nN, nwg, G, c;
    __device__ void init(int M_, int N_, int G_, int c_) { nM = M_ / BM; nN = N_ / BM; nwg = nM * nN; G = G_; c = c_; }
    __device__ bool next(int i, Unit& u) const {
        const long L = (long)i * G + c; if (L >= nwg) return false;
        int wgid = (int)L; { const int q = nwg / NXCD, r = nwg % NXCD, xcd = wgid % NXCD, off = wgid / NXCD; wgid = (xcd < r ? xcd * (q + 1) : r * (q + 1) + (xcd - r) * q) + off; }
        const int nig = WGM * nN, gid = wgid / nig, fm = gid * WGM, gsz = (nM - fm) < WGM ? (nM - fm) : WGM;
        u.pm = fm + ((wgid % nig) % gsz); u.pn = (wgid % nig) / gsz; return true;
    }
};
}

struct Job {
    const f16* A; const f16* Bt; int N, K, lda, ldb; long a_pn_off;
    int mode, ldc, tps, col_off, z24; long split_stride;
    f16* o16; float* o32; const float* f0; const f16* h0; const f16* h1; const float* xin; float* xsq; int nbj;
};

__device__ __forceinline__ unsigned pkh(float a, float b) { typedef _Float16 h2 __attribute__((ext_vector_type(2))); h2 v; v.x = (f16)a; v.y = (f16)b; return __builtin_bit_cast(unsigned, v); }
__device__ __forceinline__ void st8acc(f16* p, const f32x4& v0, const f32x4& v1) { u32x4 w; w.x = pkh(v0[0], v0[1]); w.y = pkh(v0[2], v0[3]); w.z = pkh(v1[0], v1[1]); w.w = pkh(v1[2], v1[3]); *(u32x4*)p = w; }
__device__ __forceinline__ float sigm(float x) { return __builtin_amdgcn_rcpf(1.0f + __expf(-x)); }

__device__ __forceinline__ void epilogue(const Job& J, const f32x4 (&acc)[2][2][4][2], const pg8::Unit& u, int wr, int wc, int fr, int fq) {
    const int row0 = u.pm * 256 + wr * 64 + fr, ct = wc * 32 + 8 * fq;
    if (J.mode == 0) {
        const int sp = u.pn / J.tps, cn = u.pn - sp * J.tps;
        f16* base = J.o16 + (size_t)sp * J.split_stride;
        const int ld = (J.z24 && u.pn == 24) ? 256 : J.ldc;
        const int col = cn * 256 + J.col_off + ct;
        float rs[2][4];
#pragma unroll
        for (int ai = 0; ai < 2; ++ai)
#pragma unroll
            for (int m = 0; m < 4; ++m) rs[ai][m] = J.f0 ? J.f0[row0 + ai * 128 + m * 16] : 1.0f;
#pragma unroll
        for (int ai = 0; ai < 2; ++ai)
#pragma unroll
            for (int m = 0; m < 4; ++m) { const int row = row0 + ai * 128 + m * 16; f16* rowp = base + (size_t)row * ld + col;
                const float r = J.f0 ? __builtin_amdgcn_rsqf(rs[ai][m] * (1.0f / D) + 1e-6f) : 1.0f;
#pragma unroll
                for (int bj = 0; bj < 2; ++bj) if (bj < J.nbj) st8acc(rowp + bj * 128, acc[ai][bj][m][0] * r, acc[ai][bj][m][1] * r); }
    } else if (J.mode == 1) {
        const int colg = u.pn * 256 + ct;
        f32x4 sc[2][2];
#pragma unroll
        for (int bj = 0; bj < 2; ++bj) { sc[bj][0] = *(const f32x4*)(J.f0 + colg + bj * 128); sc[bj][1] = *(const f32x4*)(J.f0 + colg + bj * 128 + 4); }
#pragma unroll
        for (int ai = 0; ai < 2; ++ai) {
            f16x8 g[4][2];
#pragma unroll
            for (int m = 0; m < 4; ++m)
#pragma unroll
                for (int bj = 0; bj < 2; ++bj) g[m][bj] = *(const f16x8*)(J.h0 + (size_t)(row0 + ai * 128 + m * 16) * 1024 + colg + bj * 128);
#pragma unroll
            for (int m = 0; m < 4; ++m)
#pragma unroll
                for (int bj = 0; bj < 2; ++bj) { const size_t row = (size_t)(row0 + ai * 128 + m * 16);
                    f32x4 a0 = acc[ai][bj][m][0], a1 = acc[ai][bj][m][1];
#pragma unroll
                    for (int j = 0; j < 4; ++j) { const float g0 = (float)g[m][bj][j], g1 = (float)g[m][bj][4 + j]; a0[j] = a0[j] * sc[bj][0][j] * g0 * sigm(g0); a1[j] = a1[j] * sc[bj][1][j] * g1 * sigm(g1); }
                    st8acc(J.o16 + row * 2048 + 1024 + colg + bj * 128, a0, a1); }
        }
    } else if (J.mode == 2) {
        const int colg = u.pn * 256 + ct;
#pragma unroll
        for (int ai = 0; ai < 2; ++ai) {
            f16x8 xh[4][2];
#pragma unroll
            for (int m = 0; m < 4; ++m)
#pragma unroll
                for (int bj = 0; bj < 2; ++bj) xh[m][bj] = *(const f16x8*)(J.h1 + (size_t)(row0 + ai * 128 + m * 16) * 2048 + colg + bj * 128);
#pragma unroll
            for (int m = 0; m < 4; ++m)
#pragma unroll
                for (int bj = 0; bj < 2; ++bj) { const size_t o = (size_t)(row0 + ai * 128 + m * 16) * 2048 + colg + bj * 128;
                    f32x4 x0 = acc[ai][bj][m][0], x1 = acc[ai][bj][m][1];
#pragma unroll
                    for (int j = 0; j < 4; ++j) { x0[j] += (float)xh[m][bj][j]; x1[j] += (float)xh[m][bj][4 + j]; }
                    st8acc(J.o16 + o, x0, x1); }
        }
    } else {
        const int colg = u.pn * 256 + ct;
        f32x4 bs[2][2];
#pragma unroll
        for (int bj = 0; bj < 2; ++bj) { bs[bj][0] = *(const f32x4*)(J.f0 + colg + bj * 128); bs[bj][1] = *(const f32x4*)(J.f0 + colg + bj * 128 + 4); }
#pragma unroll
        for (int ai = 0; ai < 2; ++ai)
#pragma unroll
            for (int mh = 0; mh < 2; ++mh) {
                f16x8 pl[2][2], xm[2][2];
#pragma unroll
                for (int mm = 0; mm < 2; ++mm)
#pragma unroll
                    for (int bj = 0; bj < 2; ++bj) { const size_t o = (size_t)(row0 + ai * 128 + (mh * 2 + mm) * 16) * 2048 + colg + bj * 128;
                        pl[mm][bj] = *(const f16x8*)(J.h0 + o); xm[mm][bj] = *(const f16x8*)(J.h1 + o); }
#pragma unroll
                for (int mm = 0; mm < 2; ++mm) {
                    const int m = mh * 2 + mm, row = row0 + ai * 128 + m * 16; float q = 0.f;
#pragma unroll
                    for (int bj = 0; bj < 2; ++bj) { const size_t o = (size_t)row * 2048 + colg + bj * 128;
                        f32x4 x0, x1;
                        const f32x4 a0 = acc[ai][bj][m][0] + bs[bj][0], a1 = acc[ai][bj][m][1] + bs[bj][1];
#pragma unroll
                        for (int j = 0; j < 4; ++j) { x0[j] = (float)xm[mm][bj][j] + sigm(a0[j]) * (float)pl[mm][bj][j]; x1[j] = (float)xm[mm][bj][4 + j] + sigm(a1[j]) * (float)pl[mm][bj][4 + j]; }
                        if (J.o32) { *(f32x4*)(J.o32 + o) = x0; *(f32x4*)(J.o32 + o + 4) = x1; } else st8acc(J.o16 + o, x0, x1);
                        q += ((x0[0] * x0[0] + x0[1] * x0[1]) + (x0[2] * x0[2] + x0[3] * x0[3])) + ((x1[0] * x1[0] + x1[1] * x1[1]) + (x1[2] * x1[2] + x1[3] * x1[3])); }
                    q += __shfl_xor(q, 16); q += __shfl_xor(q, 32);
                    if (fq == 0) atomicAdd(J.xsq + row, q);
                }
            }
    }
}

__device__ __forceinline__ void gemm_phase(LAS unsigned char* lds, const Job& g, const pg8::StaticOrder& S) {
    using namespace pg8;
    const int tid = threadIdx.x, wid = __builtin_amdgcn_readfirstlane(tid >> 6), lane = tid & 63, wr = wid >> 2, wc = wid & 3, fr = lane & 15, fq = lane >> 4;
    const int K = g.K, nt = K / BK;
    unsigned voffA[2], voffB[2];
#pragma unroll
    for (int i = 0; i < 2; ++i) { int R, C; stage_rc(tid * 16 + i * 8192, R, C); const int Rb = (R & ~31) + perm32(R & 31);
        voffA[i] = (unsigned)(R * g.lda + C) * 2u; voffB[i] = (unsigned)(Rb * g.ldb + C) * 2u; }
    const size_t kstep = (size_t)(BK * 2);
    const size_t hA = (size_t)HALF * g.lda * 2, hB = (size_t)HALF * g.ldb * 2;
    const size_t tA = 2 * hA, tB = 2 * hB;
    const unsigned ldsw = (unsigned)wid * 1024u;
    const int aoff = lds_byte(wr * 64 + fr, fq * 8), boff = lds_byte(wc * 32 + fr, fq * 8);
#define PG8_SA(b, h) (((b) * 2 + (h)) * HTB)
#define PG8_SB(b, h) ((4 + (b) * 2 + (h)) * HTB)
#define PG8_STAGE(bufoff, gbase, voff) do { _Pragma("unroll") for (int _i = 0; _i < 2; ++_i) \
        __builtin_amdgcn_global_load_lds((const unsigned*)((const char*)(gbase) + (voff)[_i]), (LAS unsigned*)(lds + (bufoff) + ldsw + _i * 8192), 16, 0, 0); } while (0)
#define PG8_LDA(dst, b, h) do { _Pragma("unroll") for (int m = 0; m < 4; ++m) _Pragma("unroll") for (int k = 0; k < 2; ++k) dst[m][k] = *(const LAS f16x8*)(lds + PG8_SA(b, h) + aoff + m * 2048 + k * 1024); } while (0)
#define PG8_LDB(dst, b, h) do { _Pragma("unroll") for (int n = 0; n < 2; ++n) _Pragma("unroll") for (int k = 0; k < 2; ++k) dst[n][k] = *(const LAS f16x8*)(lds + PG8_SB(b, h) + boff + n * 2048 + k * 1024); } while (0)
#define PG8_MMA(ai, bj, At, Bt) do { __builtin_amdgcn_s_setprio(1); _Pragma("unroll") for (int m = 0; m < 4; ++m) _Pragma("unroll") for (int n = 0; n < 2; ++n) _Pragma("unroll") for (int k = 0; k < 2; ++k) \
        acc[ai][bj][m][n] = __builtin_amdgcn_mfma_f32_16x16x32_f16(Bt[n][k], At[m][k], acc[ai][bj][m][n], 0, 0, 0); __builtin_amdgcn_s_setprio(0); } while (0)
#define PG8_WAIT_V(n) asm volatile("s_waitcnt vmcnt(" #n ")" ::: "memory")
#define PG8_WAIT_L(n) asm volatile("s_waitcnt lgkmcnt(" #n ")" ::: "memory")
#define PG8_BAR __builtin_amdgcn_s_barrier()
#define PG8_SCHED __builtin_amdgcn_sched_barrier(0)
    Unit cur, nxt; int ui = 0;
    if (!S.next(0, cur)) return;
    f32x4 acc[2][2][4][2];
#pragma unroll
    for (int a = 0; a < 2; ++a)
#pragma unroll
        for (int b = 0; b < 2; ++b)
#pragma unroll
            for (int m = 0; m < 4; ++m)
#pragma unroll
                for (int n = 0; n < 2; ++n) acc[a][b][m][n] = (f32x4){0.f, 0.f, 0.f, 0.f};
    f16x8 At[4][2], B0[2][2], B1[2][2];
    const char* cA = (const char*)g.A + (size_t)cur.pm * tA + (size_t)cur.pn * g.a_pn_off; const char* cB = (const char*)g.Bt + (size_t)cur.pn * tB;
    PG8_STAGE(PG8_SB(0, 0), cB, voffB); PG8_STAGE(PG8_SA(0, 0), cA, voffA); PG8_STAGE(PG8_SB(0, 1), cB + hB, voffB); PG8_STAGE(PG8_SA(0, 1), cA + hA, voffA);
    if (wr == 1) PG8_BAR;
    PG8_WAIT_V(4); PG8_BAR;
    PG8_STAGE(PG8_SB(1, 0), cB + kstep, voffB); PG8_STAGE(PG8_SA(1, 0), cA + kstep, voffA); PG8_STAGE(PG8_SB(1, 1), cB + hB + kstep, voffB);
    PG8_WAIT_V(6); PG8_BAR;
    for (;;) {
        const bool has_next = S.next(ui + 1, nxt);
        const char* nA = has_next ? (const char*)g.A + (size_t)nxt.pm * tA + (size_t)nxt.pn * g.a_pn_off : cA; const char* nB = has_next ? (const char*)g.Bt + (size_t)nxt.pn * tB : cB;
        for (int t = 0; t < nt; t += 2) {
            const bool last = (t == nt - 2);
            const char* a1 = cA + (size_t)(t + 1) * kstep;
            const char* a2 = last ? nA : cA + (size_t)(t + 2) * kstep; const char* b2 = last ? nB : cB + (size_t)(t + 2) * kstep;
            const char* a3 = a2 + kstep; const char* b3 = b2 + kstep;
            PG8_LDB(B0, 0, 0); PG8_SCHED; PG8_LDA(At, 0, 0); PG8_STAGE(PG8_SA(1, 1), a1 + hA, voffA);
            PG8_WAIT_L(8); PG8_BAR; PG8_WAIT_L(0); PG8_MMA(0, 0, At, B0); PG8_BAR; PG8_SCHED;
            PG8_LDB(B1, 0, 1); PG8_STAGE(PG8_SB(0, 0), b2, voffB);
            PG8_BAR; PG8_WAIT_L(0); PG8_MMA(0, 1, At, B1); PG8_BAR;
            PG8_LDA(At, 0, 1); PG8_STAGE(PG8_SA(0, 0), a2, voffA);
            PG8_BAR; PG8_WAIT_L(0); PG8_MMA(1, 0, At, B0); PG8_BAR; PG8_SCHED;
            PG8_STAGE(PG8_SB(0, 1), b2 + hB, voffB);
            PG8_WAIT_V(6); PG8_BAR; PG8_MMA(1, 1, At, B1); PG8_BAR;
            PG8_LDB(B0, 1, 0); PG8_SCHED; PG8_LDA(At, 1, 0); PG8_STAGE(PG8_SA(0, 1), a2 + hA, voffA);
            PG8_WAIT_L(8); PG8_BAR; PG8_WAIT_L(0); PG8_MMA(0, 0, At, B0); PG8_BAR; PG8_SCHED;
            PG8_LDB(B1, 1, 1); PG8_STAGE(PG8_SB(1, 0), b3, voffB);
            PG8_BAR; PG8_WAIT_L(0); PG8_MMA(0, 1, At, B1); PG8_BAR;
            PG8_LDA(At, 1, 1); PG8_STAGE(PG8_SA(1, 0), a3, voffA);
            PG8_BAR; PG8_WAIT_L(0); PG8_MMA(1, 0, At, B0); PG8_BAR; PG8_SCHED;
            PG8_STAGE(PG8_SB(1, 1), b3 + hB, voffB);
            PG8_WAIT_V(6); PG8_BAR; PG8_MMA(1, 1, At, B1); PG8_BAR;
        }
        epilogue(g, acc, cur, wr, wc, fr, fq);
        if (!has_next) break;
#pragma unroll
        for (int a = 0; a < 2; ++a)
#pragma unroll
            for (int b = 0; b < 2; ++b)
#pragma unroll
                for (int m = 0; m < 4; ++m)
#pragma unroll
                    for (int n = 0; n < 2; ++n) acc[a][b][m][n] = (f32x4){0.f, 0.f, 0.f, 0.f};
        cur = nxt; cA = nA; cB = nB; ++ui;
    }
    PG8_WAIT_V(0);
    if (wr == 0) PG8_BAR;
    PG8_BAR;
#undef PG8_SA
#undef PG8_SB
#undef PG8_STAGE
#undef PG8_LDA
#undef PG8_LDB
#undef PG8_MMA
#undef PG8_WAIT_V
#undef PG8_WAIT_L
#undef PG8_BAR
#undef PG8_SCHED
}

#define LDS_WAIT() asm volatile("s_waitcnt lgkmcnt(0)" ::: "memory")
template <int CTRL> __device__ __forceinline__ float dppf(float x) { return __builtin_bit_cast(float, __builtin_amdgcn_update_dpp(0, __builtin_bit_cast(int, x), CTRL, 0xF, 0xF, true)); }
__device__ __forceinline__ float sum8(float x) { x += dppf<0xB1>(x); x += dppf<0x4E>(x); x += dppf<0x141>(x); return x; }
__device__ __forceinline__ float sum16(float x) { x = sum8(x); x += dppf<0x140>(x); return x; }
__device__ __forceinline__ float wave_sum(float v) {
#pragma unroll
    for (int o = 1; o < 64; o <<= 1) v += __shfl_xor(v, o);
    return v;
}
__device__ __forceinline__ void ld8(const f16* p, float (&o)[8]) { const f16x8 h = *(const f16x8*)p;
#pragma unroll
    for (int i = 0; i < 8; ++i) o[i] = (float)h[i]; }
__device__ __forceinline__ void cv8(const f16x8& h, float (&o)[8]) {
#pragma unroll
    for (int i = 0; i < 8; ++i) o[i] = (float)h[i]; }
__device__ __forceinline__ void ld8nt(const f16* p, float (&o)[8]) { const f16x8 h = __builtin_nontemporal_load((const f16x8*)p);
#pragma unroll
    for (int i = 0; i < 8; ++i) o[i] = (float)h[i]; }
__device__ __forceinline__ void ldf8nt(const float* p, float (&o)[8]) { const f32x4 a = __builtin_nontemporal_load((const f32x4*)p), b = __builtin_nontemporal_load((const f32x4*)(p + 4));
#pragma unroll
    for (int i = 0; i < 4; ++i) { o[i] = a[i]; o[4 + i] = b[i]; } }
__device__ __forceinline__ void st8(f16* p, const float (&v)[8]) { u32x4 w; w.x = pkh(v[0], v[1]); w.y = pkh(v[2], v[3]); w.z = pkh(v[4], v[5]); w.w = pkh(v[6], v[7]); *(u32x4*)p = w; }
__device__ __forceinline__ void ldf8(const float* p, float (&o)[8]) { const f32x4 a = *(const f32x4*)p, b = *(const f32x4*)(p + 4);
#pragma unroll
    for (int i = 0; i < 4; ++i) { o[i] = a[i]; o[4 + i] = b[i]; } }

__device__ __forceinline__ void tr_item(const float* src, int ld_src, int k0, int c0, f16* dst, int ld_dst, int r0, int kc0, LAS float* scr, int lane, const float* gk) {
#pragma unroll 16
    for (int i = 0; i < 32; ++i) { const int kk = 2 * i + (lane >> 5); scr[kk * 33 + (lane & 31)] = __builtin_nontemporal_load(src + (size_t)(k0 + kk) * ld_src + c0 + (lane & 31)) * (gk ? gk[k0 + kk] : 1.0f); }
    LDS_WAIT();
    const int c = lane & 7;
#pragma unroll
    for (int j = 0; j < 4; ++j) { const int n = (lane >> 3) + 8 * j; const LAS float* s = scr + (8 * c) * 33 + n;
        u32x4 o; o.x = pkh(s[0 * 33], s[1 * 33]); o.y = pkh(s[2 * 33], s[3 * 33]); o.z = pkh(s[4 * 33], s[5 * 33]); o.w = pkh(s[6 * 33], s[7 * 33]);
        *(u32x4*)(dst + (size_t)(r0 + n) * ld_dst + kc0 + 8 * c) = o; }
    LDS_WAIT();
}


#define XB_TMO      128
#define XB_XCNT(j)  (256  + 64 * (j))
#define XB_XSUB(j)  (1280 + 64 * (j))
#define XB_XGEN(j)  (2304 + 64 * (j))
#define XB_TOP      3328
#define XB_TOPGEN   3392
#define XCD_BAR_WORDS 3456
#define XB_SPIN_CAP (1u << 22)
__device__ __forceinline__ unsigned xb_ld(unsigned* p)              { return __hip_atomic_load(p, __ATOMIC_RELAXED, __HIP_MEMORY_SCOPE_AGENT); }
__device__ __forceinline__ unsigned xb_add(unsigned* p, unsigned v) { return __hip_atomic_fetch_add(p, v, __ATOMIC_RELAXED, __HIP_MEMORY_SCOPE_AGENT); }
__device__ __forceinline__ unsigned xb_xcc_id() { return (unsigned)__builtin_amdgcn_s_getreg((3 << 11) | 20) & 0xFu; }
#define XB_SPIN(cond, bar) do { unsigned _sp = 0; while (cond) { __builtin_amdgcn_s_sleep(1); \
    if ((++_sp & 255u) == 0u) { if (xb_ld(&(bar)[XB_TMO])) break; if (_sp > XB_SPIN_CAP) { atomicAdd(&(bar)[XB_TMO], 1u); break; } } } } while (0)
__device__ __forceinline__ void xcd_barrier_complete(unsigned* bar, unsigned x, unsigned& nloc, unsigned& nx) {
    const unsigned G = gridDim.x * gridDim.y * gridDim.z;
    unsigned sum, cnt, mine, sp = 0u;
    for (;;) {
        sum = 0u; cnt = 0u; mine = 0u;
#pragma unroll
        for (unsigned j = 0; j < 16; ++j) { const unsigned c = xb_ld(&bar[XB_XCNT(j)]); sum += c; cnt += (c > 0u) ? 1u : 0u; mine = (j == x) ? c : mine; }
        if (sum == G) break;
        __builtin_amdgcn_s_sleep(1);
        if ((++sp & 255u) == 0u) { if (xb_ld(&bar[XB_TMO])) break; if (sp > XB_SPIN_CAP) { atomicAdd(&bar[XB_TMO], 1u); break; } }
    }
    nloc = mine > 0u ? mine : 1u; nx = cnt > 0u ? cnt : 1u;
}
__device__ __forceinline__ void xcd_barrier(unsigned* bar, volatile LAS unsigned* st) {
    asm volatile("s_waitcnt vmcnt(0)" ::: "memory");
    __syncthreads();
    if (threadIdx.x == 0) {
        const unsigned x = xb_xcc_id();
        __builtin_amdgcn_s_waitcnt(0);
        unsigned nloc = st[0], nx = st[1];
        if (nloc == 0u) { xcd_barrier_complete(bar, x, nloc, nx); st[0] = nloc; st[1] = nx; }
        const unsigned old = xb_add(&bar[XB_XSUB(x)], 1u);
        const unsigned gen = old / nloc;
        if (old + 1u == (gen + 1u) * nloc) {
            __builtin_amdgcn_fence(__ATOMIC_RELEASE, "agent");
            asm volatile("s_waitcnt vmcnt(0)" ::: "memory");
            const unsigned og = xb_add(&bar[XB_TOP], 1u);
            const unsigned tg = og / nx;
            if (og + 1u == (tg + 1u) * nx) xb_add(&bar[XB_TOPGEN], 1u);
            else XB_SPIN(xb_ld(&bar[XB_TOPGEN]) == tg, bar);
            __builtin_amdgcn_fence(__ATOMIC_ACQUIRE, "agent");
            xb_add(&bar[XB_XGEN(x)], 1u);
            asm volatile("s_waitcnt vmcnt(0)" ::: "memory");
        } else {
            XB_SPIN(xb_ld(&bar[XB_XGEN(x)]) == gen, bar);
            __builtin_amdgcn_fence(__ATOMIC_ACQUIRE, "agent");
            asm volatile("s_waitcnt vmcnt(0)" ::: "memory");
        }
    }
    __syncthreads();
}

struct Params { const float* in[24]; float* out; unsigned char* ws; };
typedef const Params __attribute__((address_space(4)))* KP;
__device__ __forceinline__ KP kparams() { auto kp = __builtin_amdgcn_kernarg_segment_ptr(); asm volatile("" : "+s"(kp)); return (KP)kp; }
enum { I_X = 0, I_P, I_NORMG, I_WIN, I_MU, I_W0, I_WUP, I_A0, I_AUP, I_V0, I_VDOWN, I_VUP, I_KK, I_KA, I_RK, I_LNW, I_LNB, I_WPOOL, I_PSCALE, I_WOUT, I_WPLE, I_WPG, I_BPG, I_FG };


#define WinT ((f16*)(ws + OFF_WIN))
#define WoutT ((f16*)(ws + OFF_WOUT))
#define WpgT ((f16*)(ws + OFF_WPG))
#define WpleT ((f16*)(ws + OFF_WPLE))
#define WpoolT ((f16*)(ws + OFF_WPOOL))
#define VdT ((f16*)(ws + OFF_VD))
#define BLT ((f16*)(ws + OFF_BL))
#define BS ((float*)(ws + OFF_BS))
#define BUFA ((f16*)(ws + OFF_BUFA))
#define Z ((f16*)(ws + OFF_Z))
#define ZL ((f16*)(ws + OFF_ZL))
#define SI ((f16*)(ws + OFF_SI))
#define VF ((f16*)(ws + OFF_VF))
#define RS ((float*)(ws + OFF_RS))
#define AL SI
#define D16 (SI + ARR)
#define Y16 (SI)
#define X16 Z
#define PL (Z + 4 * ARR)
#define P16 ZL
#define XO (kp->out)
#define XH ((f16*)kp->out)
#define XF ((float*)(ws + OFF_SI))
#define PHASE_PTRS() KP kp = kparams(); unsigned char* ws = kp->ws; int tid = threadIdx.x; asm volatile("" : "+v"(tid)); \
    const int lane = tid & 63, wid = __builtin_amdgcn_readfirstlane(tid >> 6), G = gridDim.x, gw = blockIdx.x * 8 + wid, NGW = G * 8; (void)lane; (void)gw; (void)NGW; (void)ws

__device__ __forceinline__ void rms_row(const float* xrow, const float* g, f16* o16, float* o32, int lane) {
    const f32x4* xr = (const f32x4*)xrow + lane;
    f32x4 v[8]; float s = 0.f;
#pragma unroll
    for (int j = 0; j < 8; ++j) { v[j] = xr[64 * j]; s += (v[j][0] * v[j][0] + v[j][1] * v[j][1]) + (v[j][2] * v[j][2] + v[j][3] * v[j][3]); }
    const float rstd = 1.0f / sqrtf(wave_sum(s) * (1.0f / D) + 1e-6f);
#pragma unroll
    for (int j = 0; j < 8; ++j) { const f32x4 gv = ((const f32x4*)g)[lane + 64 * j]; const f32x4 y = v[j] * rstd * gv;
        if (o16) { unsigned long long w = (unsigned long long)pkh(y[0], y[1]) | ((unsigned long long)pkh(y[2], y[3]) << 32); ((unsigned long long*)o16)[lane + 64 * j] = w; }
        else ((f32x4*)o32)[lane + 64 * j] = y; }
}

__global__ void __launch_bounds__(512, 2) fwd_megakernel(Params P) {
    extern __shared__ __attribute__((aligned(16))) unsigned char smem[];
    LAS unsigned char* lds = (LAS unsigned char*)smem;
    cg::grid_group grid = cg::this_grid();
    volatile LAS unsigned* bst = (volatile LAS unsigned*)(lds + 131072);
    { KP kp0 = kparams(); unsigned* bar0 = (unsigned*)(kp0->ws + OFF_CTL);
      if (threadIdx.x == 0) { bst[0] = 0u; bst[1] = 0u; }
      if (blockIdx.x == 0) for (int i = threadIdx.x; i < XCD_BAR_WORDS; i += 512) __hip_atomic_store(&bar0[i], 0u, __ATOMIC_RELAXED, __HIP_MEMORY_SCOPE_AGENT);
      __threadfence(); }
#pragma unroll 1
    for (int L = 0; L < 4; ++L) {
#pragma unroll 1
        for (int st = 0; st < 10; ++st) {
            int nj = 0;
            if (st == 0 && L > 0) continue;
            if (st == 0 || st == 2) {
                PHASE_PTRS();
                LAS float* scr = (LAS float*)(lds + wid * 8704);
                const int Lin = (st == 0) ? 0 : L + 1;
                const bool do_rest = (st == 2);
                const float* w_in = kp->in[I_WIN] + (size_t)(Lin < 4 ? Lin : 0) * 2048 * 6272;
                const float* gin = kp->in[I_NORMG] + (size_t)(Lin < 4 ? Lin : 0) * D;
                const float* w_out = kp->in[I_WOUT] + (size_t)L * 2048 * 2048;
                const float* w_pg = kp->in[I_WPG] + (size_t)L * 2048 * 2048;
                const float* w_ple = kp->in[I_WPLE] + (size_t)L * 256 * 2048;
                const float* w_pool = kp->in[I_WPOOL] + (size_t)L * 4 * 256 * 256;
                constexpr int N_IN_ITEMS = 32 * 196, N_SQ = 32 * 64, N_PLE = 4 * 64, N_POOL = 4 * 4 * 8;
                constexpr int N_LORA = 64;
                constexpr int NITEMS = N_IN_ITEMS + 2 * N_SQ + N_PLE + N_POOL + N_LORA;
                const float* w_upc = kp->in[I_WUP] + (size_t)L * 64 * 1024; const float* a_upc = kp->in[I_AUP] + (size_t)L * 64 * 1024;
                const int it_lo = (Lin < 4) ? 0 : N_IN_ITEMS, it_hi = do_rest ? NITEMS : N_IN_ITEMS;
                for (int it = it_lo + gw; it < it_hi; it += NGW) {
                    int r = it; const float* src; f16* dst; int ld_src, ld_dst, k0, c0, r0, kc_add = 0; const float* gk = nullptr;
                    if (r < N_IN_ITEMS) { const int kb = r / 196, nb = r % 196, c = nb * 32; r0 = (c < 3072) ? c : (c < 3200 ? c + 3072 : c - 128);
                        src = w_in; ld_src = 6272; k0 = kb * 64; c0 = c; dst = WinT; ld_dst = 2048; gk = gin; }
                    else if (r < N_IN_ITEMS + 2 * N_SQ) { r -= N_IN_ITEMS; const bool second = r >= N_SQ; if (second) r -= N_SQ; const int kb = r / 64, nb = r % 64;
                        src = second ? w_pg : w_out; ld_src = 2048; k0 = kb * 64; c0 = nb * 32; dst = second ? WpgT : WoutT; ld_dst = 2048; r0 = nb * 32; }
                    else if (r < N_IN_ITEMS + 2 * N_SQ + N_PLE) { r -= N_IN_ITEMS + 2 * N_SQ; const int kb = r / 64, nb = r % 64;
                        src = w_ple; ld_src = 2048; k0 = kb * 64; c0 = nb * 32; dst = WpleT; ld_dst = 256; r0 = nb * 32; }
                    else if (r < N_IN_ITEMS + 2 * N_SQ + N_PLE + N_POOL) { r -= N_IN_ITEMS + 2 * N_SQ + N_PLE; const int gq = r / 32, rr = r % 32, kb = rr / 8, nb = rr % 8;
                        src = w_pool + (size_t)gq * 65536; ld_src = 256; k0 = kb * 64; c0 = nb * 32; dst = WpoolT + (size_t)gq * 65536; ld_dst = 256; r0 = nb * 32; }
                    else { r -= N_IN_ITEMS + 2 * N_SQ + N_PLE + N_POOL; const bool second = r >= 32; const int nb = r & 31;
                        src = second ? a_upc : w_upc; ld_src = 1024; k0 = 0; c0 = nb * 32; dst = BLT; ld_dst = 256; r0 = (second ? 1024 : 0) + nb * 32; kc_add = second ? 64 : 0; }
                    tr_item(src, ld_src, k0, c0, dst, ld_dst, r0, k0 + kc_add, scr, lane, gk);
                }
                if (st == 0) {
                    for (int i = gw * 64 + lane; i < 128 * 2048 / 8; i += NGW * 64) *(u32x4*)(WinT + (size_t)6272 * 2048 + (size_t)i * 8) = (u32x4){0u, 0u, 0u, 0u};
                    for (int i = gw * 64 + lane; i < 3072 * 256 / 8; i += NGW * 64) *(u32x4*)(BLT + (size_t)i * 8) = (u32x4){0u, 0u, 0u, 0u};
                    for (int i = gw * 64 + lane; i < 256 * 1024 / 8; i += NGW * 64) *(u32x4*)(VdT + (size_t)i * 8) = (u32x4){0u, 0u, 0u, 0u};
                    const float* xin = kp->in[I_X];
                    for (int m = gw; m < M; m += NGW) {
                        const f32x4* xr = (const f32x4*)(xin + (size_t)m * D) + lane; float ssq = 0.f;
#pragma unroll
                        for (int j = 0; j < 8; ++j) { const f32x4 v = __builtin_nontemporal_load(xr + 64 * j); ssq += (v[0] * v[0] + v[1] * v[1]) + (v[2] * v[2] + v[3] * v[3]);
                            ((unsigned long long*)(XH + (size_t)m * D))[lane + 64 * j] = (unsigned long long)pkh(v[0], v[1]) | ((unsigned long long)pkh(v[2], v[3]) << 32); }
                        ssq = wave_sum(ssq);
                        if (lane == 0) RS[m] = ssq;
                    }
                } else {
                    for (int i = gw * 64 + lane; i < M; i += NGW * 64) RS[i] = 0.f;
                    if (L > 0) {
                        const float* v_up = kp->in[I_VUP] + (size_t)(L - 1) * 32 * 1024; const float* v_down = kp->in[I_VDOWN] + (size_t)(L - 1) * 1024 * 32;
                        for (int i = gw * 64 + lane; i < 32 * 1024; i += NGW * 64) { const int n = i >> 5, k = i & 31; BLT[(size_t)(2048 + n) * 256 + 128 + k] = (f16)v_up[k * 1024 + n]; }
                        for (int i = gw * 64 + lane; i < 32 * 1024; i += NGW * 64) { const int n = i >> 10, k = i & 1023; VdT[(size_t)n * 1024 + k] = (f16)v_down[k * 32 + n]; }
                    }
                }
            }
            if (st == 0) { }
            else if (st == 1) { nj = 1; }
            else if (st == 2) {
                PHASE_PTRS();
                const float* mu = kp->in[I_MU] + (size_t)L * 3200;
                const f16* Zv = Z + 2 * ARR; const f16* Zu = Z + 4 * ARR;
                for (int it = gw; it < 2048; it += NGW) {
                    const int ms = (it >> 1) * 32, hf = it & 1, c0 = hf * 512 + lane * 8, t0 = ms & (T - 1);
                    const int win = 2 << (c0 >> 8);
                    float sw[8], vprev[8], muv[8];
#pragma unroll
                    for (int i = 0; i < 8; ++i) { sw[i] = 0.f; vprev[i] = 0.f; }
                    ldf8(mu + 2048 + c0, muv);
                    if (t0 > 0) {
#pragma unroll
                        for (int q = 1; q < 16; ++q) if (q < win) { float pv[8]; ld8(Zu + (size_t)(ms - q) * 1024 + c0, pv);
#pragma unroll
                            for (int i = 0; i < 8; ++i) sw[i] += pv[i]; }
                        if (L > 0) ld8(Zv + (size_t)(ms - 1) * 1024 + c0, vprev);
                    }
#pragma unroll 4
                    for (int m = ms; m < ms + 32; ++m) {
                        const int t = t0 + (m - ms); const size_t o = (size_t)m * 1024 + c0;
                        float cur[8], od[8]; ld8(Zu + o, cur);
                        const int nw = (t + 1 < win) ? (t + 1) : win; const float inv = __builtin_amdgcn_rcpf((float)nw);
#pragma unroll
                        for (int i = 0; i < 8; ++i) { sw[i] += cur[i]; od[i] = sw[i] * inv - cur[i]; }
                        st8(D16 + o, od);
                        if (t - win + 1 >= 0) { float old[8]; ld8(Zu + (size_t)(m - win + 1) * 1024 + c0, old);
#pragma unroll
                            for (int i = 0; i < 8; ++i) sw[i] -= old[i]; }
                        if (L > 0) { float vr[8], ov[8]; ld8nt(Zv + o, vr);
#pragma unroll
                            for (int i = 0; i < 8; ++i) { ov[i] = vr[i] + (vprev[i] - vr[i]) * muv[i]; vprev[i] = vr[i]; }
                            st8(SI + 2 * ARR + o, ov); }
                    }
                    const int ma = ms + 16 * hf;
                    { const int c = (lane & 15) * 8, tsub = lane >> 4; float mv[8]; ldf8(mu + 3072 + c, mv);
                      f16x8 cu[4], pv[4];
#pragma unroll
                      for (int i = 0; i < 4; ++i) { const int m = ma + 4 * i + tsub; cu[i] = __builtin_nontemporal_load((const f16x8*)(ZL + (size_t)m * 256 + c));
                          if ((m & (T - 1)) > 0) pv[i] = *(const f16x8*)(ZL + (size_t)(m - 1) * 256 + c); else pv[i] = (f16x8)(0); }
#pragma unroll
                      for (int i = 0; i < 4; ++i) { const int m = ma + 4 * i + tsub; float o[8];
#pragma unroll
                          for (int e8 = 0; e8 < 8; ++e8) { const float cur = (float)cu[i][e8], z = cur + ((float)pv[i][e8] - cur) * mv[e8];
                              if (c < 64) { const float e = __expf(2.0f * z); o[e8] = 1.0f - 2.0f * __builtin_amdgcn_rcpf(e + 1.0f); } else o[e8] = z; }
                          st8(AL + (size_t)m * 256 + c, o); }
                      if (L == 0) {
#pragma unroll
                          for (int i = 0; i < 4; ++i) { const int idx = i * 64 + lane; *(u32x4*)(AL + (size_t)(ma + (idx >> 4)) * 256 + 128 + (idx & 15) * 8) = (u32x4){0u, 0u, 0u, 0u}; } }
                    }
                }
            } else if (st == 3) { nj = 2; }
            else if (st == 4) { if (L == 0) continue; nj = 1; }
            else if (st == 5) { continue; }
            else if (st == 6) {
                PHASE_PTRS();
                typedef float f32x2 __attribute__((ext_vector_type(2)));
                const int rg = lane >> 3, kq = lane & 7;
                for (int item = blockIdx.x; item < 256; item += G) {
                    const int bh = item >> 1, half = item & 1, b = bh >> 4, h = bh & 15;
                    const size_t m0 = (size_t)b * T;
                    if (wid >= 4) {
                        const int x = tid - 256, tl = x >> 3, seg = x & 7, c0 = h * 64 + seg * 8;
                        const float* mu = kp->in[I_MU] + (size_t)L * 3200;
                        float mur[8], muk[8], muv[8], w0v[8], a0v[8], v0v[8], kkp[8], kap[8], rkp[8];
                        ldf8(mu + c0, mur); ldf8(mu + 1024 + c0, muk); ldf8(mu + 2048 + c0, muv);
                        ldf8(kp->in[I_W0] + (size_t)L * 1024 + c0, w0v); ldf8(kp->in[I_A0] + (size_t)L * 1024 + c0, a0v);
                        ldf8(kp->in[I_V0] + (size_t)(L > 0 ? L - 1 : 0) * 1024 + c0, v0v);
                        ldf8(kp->in[I_KK] + (size_t)L * 1024 + c0, kkp); ldf8(kp->in[I_KA] + (size_t)L * 1024 + c0, kap); ldf8(kp->in[I_RK] + (size_t)L * 1024 + c0, rkp);
                        const f16* Zr = Z; const f16* Zk = Z + ARR; const f16* Zv = Z + 2 * ARR;
                        const size_t gbase = (m0 + tl) * 1024 + c0;
                        const unsigned loff = (unsigned)(tl * 1280 + seg * 32);
                        constexpr int NC = T / 32;
                        f16x8 q[9];
#pragma unroll
                        for (int i = 0; i < 9; ++i) q[i] = (f16x8)(0);
#define FS_LOAD(ch) do { const size_t _o = gbase + (size_t)(ch) * 32 * 1024; const bool _first = ((ch) == 0 && tl == 0); \
        q[0] = *(const f16x8*)(Zr + _o); q[2] = *(const f16x8*)(Zk + _o); q[4] = *(const f16x8*)(SI + 3 * ARR + _o); q[5] = *(const f16x8*)(SI + 4 * ARR + _o); \
        if (!_first) { q[1] = *(const f16x8*)(Zr + _o - 1024); q[3] = *(const f16x8*)(Zk + _o - 1024); } else { q[1] = (f16x8)(0); q[3] = (f16x8)(0); } \
        if (L == 0) { q[6] = *(const f16x8*)(Zv + _o); if (!_first) q[7] = *(const f16x8*)(Zv + _o - 1024); else q[7] = (f16x8)(0); } \
        else { q[6] = *(const f16x8*)(SI + 2 * ARR + _o); q[7] = *(const f16x8*)(SI + 5 * ARR + _o); q[8] = *(const f16x8*)(VF + _o); } } while (0)
                        FS_LOAD(0);
#pragma unroll 1
                        for (int c = 0; c <= NC; ++c) {
                            if (c < NC) {
                                float rr[8], rp[8], kr[8], kq8[8], lw[8], la[8], vv[8];
                                cv8(q[0], rr); cv8(q[1], rp); cv8(q[2], kr); cv8(q[3], kq8); cv8(q[4], lw); cv8(q[5], la);
                                if (L == 0) { float vr[8], vp[8]; cv8(q[6], vr); cv8(q[7], vp);
#pragma unroll
                                    for (int i = 0; i < 8; ++i) vv[i] = vr[i] + (vp[i] - vr[i]) * muv[i]; }
                                else { float lv[8], vf[8]; cv8(q[6], vv); cv8(q[7], lv); cv8(q[8], vf);
#pragma unroll
                                    for (int i = 0; i < 8; ++i) { const float nu = sigm(v0v[i] + lv[i]); vv[i] = vv[i] + (vf[i] - vv[i]) * nu; } }
                                float ro[8], ko[8], ewv[8], bo[8], nk[8]; float ss = 0.f, bsum = 0.f;
#pragma unroll
                                for (int i = 0; i < 8; ++i) {
                                    const float r = rr[i] + (rp[i] - rr[i]) * mur[i], k = kr[i] + (kq8[i] - kr[i]) * muk[i];
                                    const float ew = sigm(w0v[i] + lw[i]) * 0.6065306597126334f;
                                    ewv[i] = ew;
                                    const float a = sigm(a0v[i] + la[i]);
                                    const float kkv = k * kkp[i]; ss += kkv * kkv; nk[i] = kkv; bo[i] = a;
                                    const float k2 = k * (1.0f + (a - 1.0f) * kap[i]);
                                    ro[i] = r; ko[i] = k2; bsum += r * k2 * rkp[i];
                                }
                                ss = sum8(ss); bsum = sum8(bsum);
                                const float inv = __builtin_amdgcn_rsqf(fmaxf(ss, 1e-24f));
#pragma unroll
                                for (int i = 0; i < 8; ++i) { const float kk = nk[i] * inv; nk[i] = -kk; bo[i] = kk * bo[i]; }
                                float G[8];
#pragma unroll
                                for (int i = 0; i < 8; ++i) G[i] = ewv[i];
#pragma unroll
                                for (int d = 8; d < 64; d <<= 1) {
#pragma unroll
                                    for (int i = 0; i < 8; ++i) { const float up = __shfl_up(G[i], d); if (lane >= d) G[i] += up; } }
                                float ecur[8];
#pragma unroll
                                for (int i = 0; i < 8; ++i) { const float ec = __expf(-G[i]), ei = __expf(G[i]), ep = __expf(ewv[i] - G[i]);
                                    ecur[i] = ec; nk[i] *= ep; ro[i] *= ec; bo[i] *= ei; ko[i] *= ei; }
                                LAS unsigned char* nbuf = lds + (c & 1) * 41984;
                                LAS unsigned char* nb = nbuf + loff;
#define FS_PUT(a, arr) do { *(LAS f32x4*)(nb + (a) * 256) = (f32x4){arr[0], arr[1], arr[2], arr[3]}; *(LAS f32x4*)(nb + (a) * 256 + 16) = (f32x4){arr[4], arr[5], arr[6], arr[7]}; } while (0)
                                FS_PUT(0, nk); FS_PUT(1, bo); FS_PUT(2, ko); FS_PUT(3, ro); FS_PUT(4, vv);
                                if ((lane >> 3) == 7) { LAS unsigned char* gt = nbuf + 40960 + (tl >> 3) * 256 + seg * 32;
                                    *(LAS f32x4*)(gt) = (f32x4){ecur[0], ecur[1], ecur[2], ecur[3]}; *(LAS f32x4*)(gt + 16) = (f32x4){ecur[4], ecur[5], ecur[6], ecur[7]}; }
                                if (half == 0) { const size_t o = gbase + (size_t)c * 32 * 1024;
                                    st8(SI + ARR + o, vv);
                                    if (L == 0) st8(VF + o, vv);
                                    if (seg == 0) BS[(m0 + (size_t)c * 32 + tl) * 16 + h] = bsum; }
                                if (c + 1 < NC) FS_LOAD(c + 1);
                            }
                            __syncthreads();
                        }
                    } else {
                        const int row = half * 32 + wid * 8 + rg;
                        f32x2 Sa = {0.f, 0.f}, Sb = {0.f, 0.f}, Sc = {0.f, 0.f}, Sd = {0.f, 0.f};
                        f16* yout = Y16 + m0 * 1024 + h * 64 + row;
                        __builtin_amdgcn_s_setprio(3);
                        __syncthreads();
#pragma unroll 1
                        for (int c = 0; c < T / 32; ++c) {
                            const LAS unsigned char* buf = lds + (c & 1) * 41984;
                            const LAS unsigned char* pk = buf + kq * 32; const LAS unsigned char* pv = buf + 1024 + row * 4;
#define SCAN_LOAD(dst, dv, stp) do { const LAS unsigned char* _p = pk + (stp) * 1280; \
        dst[0] = *(const LAS f32x4*)(_p); dst[1] = *(const LAS f32x4*)(_p + 16); dst[2] = *(const LAS f32x4*)(_p + 256); dst[3] = *(const LAS f32x4*)(_p + 272); \
        dst[4] = *(const LAS f32x4*)(_p + 512); dst[5] = *(const LAS f32x4*)(_p + 528); dst[6] = *(const LAS f32x4*)(_p + 768); dst[7] = *(const LAS f32x4*)(_p + 784); \
        dv = *(const LAS float*)(pv + (stp) * 1280); } while (0)
                            f32x4 rg2[2][8]; float rv2[2];
                            SCAN_LOAD(rg2[0], rv2[0], 0);
#pragma unroll
                            for (int tt = 0; tt < 32; tt += 8) {
                                float yk = 0.f;
                                const f32x4 ge0 = *(const LAS f32x4*)(pk + 40960 + (tt >> 3) * 256), ge1 = *(const LAS f32x4*)(pk + 40960 + (tt >> 3) * 256 + 16);
#pragma unroll
                                for (int j = 0; j < 8; ++j) {
                                    if (j < 7 || tt + 8 < 32) SCAN_LOAD(rg2[(j + 1) & 1], rv2[(j + 1) & 1], tt + j + 1);
                                    __builtin_amdgcn_sched_barrier(0);
                                    const f32x4 (&cur)[8] = rg2[j & 1]; const float curv = rv2[j & 1];
                                    const f32x2 v2 = {curv, curv};
                                    const f32x2 pa = v2 * cur[4].xy + Sa, pb = v2 * cur[4].zw + Sb, pc = v2 * cur[5].xy + Sc, pd = v2 * cur[5].zw + Sd;
                                    f32x2 t0 = Sa * cur[0].xy; t0 = Sb * cur[0].zw + t0;
                                    f32x2 t1 = Sc * cur[1].xy; t1 = Sd * cur[1].zw + t1;
                                    const f32x2 t = t0 + t1;
                                    float sa = sum8(t.x + t.y);
                                    const f32x2 sa2 = {sa, sa};
                                    Sa = sa2 * cur[2].xy + pa; Sb = sa2 * cur[2].zw + pb; Sc = sa2 * cur[3].xy + pc; Sd = sa2 * cur[3].zw + pd;
                                    f32x2 u0 = Sa * cur[6].xy; u0 = Sb * cur[6].zw + u0;
                                    f32x2 u1 = Sc * cur[7].xy; u1 = Sd * cur[7].zw + u1;
                                    const f32x2 u = u0 + u1;
                                    const float y = sum8(u.x + u.y);
                                    yk = (kq == j) ? y : yk;
                                }
                                Sa *= ge0.xy; Sb *= ge0.zw; Sc *= ge1.xy; Sd *= ge1.zw;
                                yout[(size_t)(c * 32 + tt + kq) * 1024] = (f16)yk;
                            }
                            __syncthreads();
                        }
                        __builtin_amdgcn_s_setprio(0);
                    }
                }
            } else if (st == 7) {
                PHASE_PTRS();
                const f16* Zg = Z + 3 * ARR;
                for (int it = gw; it < 2048; it += NGW) {
                    const int ms = (it >> 1) * 32, c0 = (it & 1) * 512 + lane * 8, head = c0 >> 6;
                    float lnw[8], lnb[8]; ldf8(kp->in[I_LNW] + (size_t)L * 1024 + c0, lnw); ldf8(kp->in[I_LNB] + (size_t)L * 1024 + c0, lnb);
#pragma unroll 2
                    for (int m = ms; m < ms + 32; ++m) {
                        const size_t o = (size_t)m * 1024 + c0;
                        float y[8], v[8], g[8], out[8]; ld8nt(Y16 + o, y); ld8nt(SI + ARR + o, v); ld8nt(Zg + o, g);
                        const float bs = BS[(size_t)m * 16 + head];
                        float s = 0.f;
#pragma unroll
                        for (int i = 0; i < 8; ++i) s += y[i];
                        const float mean = sum8(s) * (1.0f / 64.0f); float q = 0.f;
#pragma unroll
                        for (int i = 0; i < 8; ++i) { y[i] -= mean; q += y[i] * y[i]; }
                        const float rstd = __builtin_amdgcn_rsqf(sum8(q) * (1.0f / 64.0f) + 64e-5f);
#pragma unroll
                        for (int i = 0; i < 8; ++i) out[i] = (y[i] * rstd * lnw[i] + lnb[i] + bs * v[i]) * g[i] * sigm(g[i]);
                        st8(BUFA + (size_t)m * 2048 + c0, out);
                    }
                }
                const float* pL = kp->in[I_P] + (size_t)L * M * 256;
                for (size_t i = (size_t)gw * 64 + lane; i < (size_t)M * 256 / 8; i += (size_t)NGW * 64) { float v[8]; ldf8nt(pL + i * 8, v); st8(P16 + i * 8, v); }
            } else if (st == 8) { nj = 2; }
            else { nj = 1; }

#pragma unroll 1
            for (int j = 0; j < nj; ++j) {
                PHASE_PTRS(); const float* xin = (L == 0) ? kp->in[I_X] : XO;
                Job J; J.a_pn_off = 0; J.z24 = 0; J.tps = 1 << 20; J.col_off = 0; J.split_stride = 0; J.o16 = nullptr; J.o32 = nullptr; J.f0 = nullptr; J.h0 = nullptr; J.h1 = nullptr; J.nbj = 2; J.xin = nullptr; J.xsq = nullptr; J.mode = 0; J.ldc = 0;
                if (st == 1) { J.A = XH; J.Bt = WinT; J.N = NZ; J.K = 2048; J.lda = 2048; J.ldb = 2048; J.o16 = Z; J.ldc = 1024; J.tps = 4; J.split_stride = (long)ARR; J.z24 = 1; J.f0 = RS; }
                else if (st == 3 && j == 0) { J.A = D16; J.Bt = WpoolT; J.N = 1024; J.K = 256; J.lda = 1024; J.ldb = 256; J.a_pn_off = 512; J.mode = 1;
                    J.f0 = kp->in[I_PSCALE] + (size_t)L * 1024; J.h0 = Z + 5 * ARR; J.o16 = BUFA; }
                else if (st == 3 && L > 0) { J.A = SI + 2 * ARR; J.Bt = VdT; J.N = 256; J.K = 1024; J.lda = 1024; J.ldb = 1024; J.o16 = AL; J.ldc = 256; J.col_off = 128; J.nbj = 1; }
                else if (st == 4 || st == 3) { J.A = AL; J.Bt = BLT; J.N = (L > 0) ? 3072 : 2048  ; J.K = 256; J.lda = 256; J.ldb = 256; J.o16 = SI + 3 * ARR; J.ldc = 1024; J.tps = 4; J.split_stride = (long)ARR; }
                else if (st == 8 && j == 0) { J.A = BUFA; J.Bt = WoutT; J.N = 2048; J.K = 2048; J.lda = 2048; J.ldb = 2048; J.mode = 2; J.h1 = XH; J.o16 = X16; }
                else if (st == 8) { J.A = P16; J.Bt = WpleT; J.N = 2048; J.K = 256; J.lda = 256; J.ldb = 256; J.o16 = PL; J.ldc = 2048; }
                else { J.A = X16; J.Bt = WpgT; J.N = 2048; J.K = 2048; J.lda = 2048; J.ldb = 2048; J.mode = 3; J.f0 = kp->in[I_BPG] + (size_t)L * 2048; J.h0 = PL; J.h1 = X16; J.o16 = (L == 3) ? BUFA : XH; J.xsq = RS; }
                pg8::StaticOrder S; S.init(M, J.N, G, (int)blockIdx.x);
                gemm_phase(lds, J, S);
            }
            if (L == 0 && st == 0) {
                grid.sync();
                KP kp0 = kparams(); unsigned* bar0 = (unsigned*)(kp0->ws + OFF_CTL);
                if (threadIdx.x == 0) (void)xb_add(&bar0[XB_XCNT(xb_xcc_id())], 1u);
                __syncthreads();
            } else { KP kpb = kparams(); xcd_barrier((unsigned*)(kpb->ws + OFF_CTL), bst); }
        }
    }
    PHASE_PTRS();
    for (int m = gw; m < M; m += NGW) {
        const float rstd = __builtin_amdgcn_rsqf(RS[m] * (1.0f / D) + 1e-6f);
        const f16* xr = BUFA + (size_t)m * D; const float* fg = kp->in[I_FG]; float* orow = XO + (size_t)m * D;
        f16x8 xv[4];
#pragma unroll
        for (int j = 0; j < 4; ++j) xv[j] = __builtin_nontemporal_load((const f16x8*)(xr + lane * 8 + 512 * j));
#pragma unroll
        for (int j = 0; j < 4; ++j) { const int c = lane * 8 + 512 * j; const f32x4 g0 = *(const f32x4*)(fg + c), g1 = *(const f32x4*)(fg + c + 4); f32x4 o0, o1;
#pragma unroll
            for (int i = 0; i < 4; ++i) { o0[i] = (float)xv[j][i] * rstd * g0[i]; o1[i] = (float)xv[j][4 + i] * rstd * g1[i]; }
            __builtin_nontemporal_store(o0, (f32x4*)(orow + c)); __builtin_nontemporal_store(o1, (f32x4*)(orow + c + 4)); }
    }
}

extern "C" void kernel_launch(void* const* d_in, const int* in_sizes, int n_in, void* d_out, int out_size, void* d_ws, size_t ws_size, hipStream_t stream) {
    constexpr int kDynLds = 131072 + 64;
    static int grid_blocks = 0;
    if (!grid_blocks) {
        if (n_in != 24 || ws_size < WS_END) { fprintf(stderr, "kernel_launch: need 24 inputs and %zu bytes of workspace, got %d / %zu\n", (size_t)WS_END, n_in, ws_size); grid_blocks = -1; return; }
        int dev = 0, cus = 0, per_cu = 0;
        hipGetDevice(&dev);
        hipDeviceGetAttribute(&cus, hipDeviceAttributeMultiprocessorCount, dev);
        hipFuncSetAttribute((const void*)fwd_megakernel, hipFuncAttributeMaxDynamicSharedMemorySize, kDynLds);
        hipOccupancyMaxActiveBlocksPerMultiprocessor(&per_cu, (const void*)fwd_megakernel, 512, kDynLds);
        if (per_cu < 1) per_cu = 1;
        grid_blocks = cus * per_cu;
        if (grid_blocks > 256) grid_blocks = 256;
    }
    if (grid_blocks < 0) return;
    Params p{};
    for (int i = 0; i < 24; ++i) p.in[i] = (const float*)d_in[i];
    p.out = (float*)d_out; p.ws = (unsigned char*)d_ws;
    void* args[] = {&p};
    hipError_t e = hipLaunchCooperativeKernel((const void*)fwd_megakernel, dim3(grid_blocks), dim3(512), args, kDynLds, stream);
    if (e != hipSuccess) fprintf(stderr, "cooperative launch failed: %s (grid %d)\n", hipGetErrorString(e), grid_blocks);
}
```
